# Optimizing an MI355X kernel written in HIP

```python
import math
import jax, jax.numpy as jnp
from jax import lax
import numpy as np

D_MODEL = 2048
BATCH = 4
SEQ = 4096
DEPTH = 1

HEAD_DIM = 64
DILATION_PATTERNS = ((128, 1), (512, 4), (2048, 16))
N_ATT_GROUPS = len(DILATION_PATTERNS)
HEADS_PER_GROUP = 6
N_Q_HEADS = N_ATT_GROUPS * HEADS_PER_GROUP
KV_HEADS = HEADS_PER_GROUP
ATT_Q_WIDTH = N_Q_HEADS * HEAD_DIM
KV_WIDTH = KV_HEADS * HEAD_DIM
ROT_DIM = HEAD_DIM // 4
ROPE_THETA = 500000.0
BLK = 128
SSM_WIDTH = D_MODEL - ATT_Q_WIDTH
SSM_GROUP_CH = 16
SSM_GROUPS = SSM_WIDTH // SSM_GROUP_CH
SSM_STATE = 64
IN_WIDTH = ATT_Q_WIDTH + 2 * KV_WIDTH + SSM_WIDTH
OUT_IN_WIDTH = KV_WIDTH + SSM_WIDTH
D_FF = 4 * D_MODEL
N_MOD = 6
EPS = 1e-6

kernel_name = "hymba_s5_longnet_sandwich_adaln_block"


def rms_norm(x, g):
    xf = x.astype(jnp.float32)
    y = xf * lax.rsqrt(jnp.mean(xf * xf, axis=-1, keepdims=True) + EPS)
    return (y * g.astype(jnp.float32)).astype(x.dtype)


def rope_partial(t, positions):
    freqs = ROPE_THETA ** (-jnp.arange(0, ROT_DIM, 2, dtype=jnp.float32) / ROT_DIM)
    ang = positions.astype(jnp.float32)[..., None] * freqs
    cos = jnp.cos(ang)[:, :, None, :]
    sin = jnp.sin(ang)[:, :, None, :]
    tr = t[..., :ROT_DIM].astype(jnp.float32)
    x1, x2 = tr[..., :ROT_DIM // 2], tr[..., ROT_DIM // 2:]
    rot = jnp.concatenate([x1 * cos - x2 * sin, x2 * cos + x1 * sin], axis=-1).astype(t.dtype)
    return jnp.concatenate([rot, t[..., ROT_DIM:]], axis=-1)


def dilated_window_attention(q, k, v, dilation, span):
    assert span <= BLK
    B, L, H, Dh = q.shape
    n = L // dilation

    def to_sub(t):
        return t.reshape(B, n, dilation, H, Dh).transpose(0, 2, 3, 1, 4)

    qs, ks, vs = to_sub(q), to_sub(k), to_sub(v)
    n_pad = -(-n // BLK) * BLK
    pad = ((0, 0), (0, 0), (0, 0), (0, n_pad - n), (0, 0))
    qs, ks, vs = (jnp.pad(t, pad) for t in (qs, ks, vs))
    nb = n_pad // BLK
    qb = qs.reshape(B, dilation, H, nb, BLK, Dh)
    kb = ks.reshape(B, dilation, H, nb, BLK, Dh)
    vb = vs.reshape(B, dilation, H, nb, BLK, Dh)

    def with_prev(t):
        prev = jnp.concatenate([jnp.zeros_like(t[:, :, :, :1]), t[:, :, :, :-1]], axis=3)
        return jnp.concatenate([prev, t], axis=4)

    kc, vc = with_prev(kb), with_prev(vb)
    scores = jnp.einsum('brhnqe,brhnke->brhnqk', qb, kc).astype(jnp.float32) / math.sqrt(Dh)
    blk = jnp.arange(nb)[:, None, None]
    qi = jnp.arange(BLK)[None, :, None]
    kj = jnp.arange(2 * BLK)[None, None, :]
    dist = qi + BLK - kj
    valid = (dist >= 0) & (dist <= span) & (blk * BLK - BLK + kj >= 0)
    scores = jnp.where(valid, scores, -jnp.inf)
    lse = jax.nn.logsumexp(scores, axis=-1)
    p = jnp.exp(scores - lse[..., None]).astype(v.dtype)
    out = jnp.einsum('brhnqk,brhnke->brhnqe', p, vc)
    out = out.reshape(B, dilation, H, n_pad, Dh)[:, :, :, :n]
    out = out.transpose(0, 3, 1, 2, 4).reshape(B, L, H, Dh)
    lse = lse.reshape(B, dilation, H, n_pad)[:, :, :, :n].transpose(0, 3, 1, 2).reshape(B, L, H)
    return out, lse


def _scan_op(e1, e2):
    a1, b1 = e1
    a2, b2 = e2
    return a1 * a2, a2 * b1 + b2


def s5_mixer(u, a_re, a_im, log_dt, b_re, b_im, c_re, c_im, d_skip, w_glu, b_glu):
    B, L, G, P = u.shape
    u32 = u.astype(jnp.float32)
    lam = lax.complex(a_re.astype(jnp.float32), a_im.astype(jnp.float32))
    dt = jnp.exp(log_dt.astype(jnp.float32))[:, None]
    a_bar = jnp.exp(lam * dt)
    b_mat = lax.complex(b_re.astype(jnp.float32), b_im.astype(jnp.float32))
    b_bar = ((a_bar - 1.0) / lam)[..., None] * b_mat
    c_mat = lax.complex(c_re.astype(jnp.float32), c_im.astype(jnp.float32))
    bu = jnp.einsum('blgp,gnp->blgn', u32.astype(jnp.complex64), b_bar)
    a_all = jnp.broadcast_to(a_bar, bu.shape)
    _, state = lax.associative_scan(_scan_op, (a_all, bu), axis=1)
    y = jnp.einsum('blgn,gpn->blgp', state, c_mat).real + d_skip.astype(jnp.float32) * u32
    y = y.reshape(B, L, G * P)
    y = jax.nn.gelu(y)
    y = y * jax.nn.sigmoid(y @ w_glu.astype(jnp.float32) + b_glu.astype(jnp.float32))
    return y.astype(u.dtype)


def setup_inputs(seed: int = 0) -> dict:
    key = jax.random.key(seed)
    ks = jax.random.split(key, 32)
    f32 = jnp.float32
    nrm = lambda k, shape, s: jax.random.normal(k, shape, f32) * s
    x = jax.random.normal(ks[0], (BATCH, SEQ, D_MODEL), f32)
    c = jax.random.normal(ks[1], (BATCH, D_MODEL), f32)
    offset = jax.random.randint(ks[2], (BATCH, 1), 0, 1024, dtype=jnp.int32)
    positions = (offset + jnp.arange(SEQ, dtype=jnp.int32)[None, :]).astype(jnp.int32)
    n_idx = jnp.arange(SSM_STATE, dtype=f32)
    return {
        "x": x,
        "c": c,
        "positions": positions,
        "w_ada": nrm(ks[3], (DEPTH, D_MODEL, N_MOD * D_MODEL), 0.5 * D_MODEL ** -0.5),
        "b_ada": nrm(ks[4], (DEPTH, N_MOD * D_MODEL), 0.01),
        "g_pre_mix": 1.0 + nrm(ks[5], (DEPTH, D_MODEL), 0.02),
        "g_post_mix": 1.0 + nrm(ks[6], (DEPTH, D_MODEL), 0.02),
        "w_in": nrm(ks[7], (DEPTH, D_MODEL, IN_WIDTH), D_MODEL ** -0.5),
        "ssm_a_re": -0.5 + nrm(ks[8], (DEPTH, SSM_GROUPS, SSM_STATE), 0.01),
        "ssm_a_im": math.pi * n_idx + nrm(ks[9], (DEPTH, SSM_GROUPS, SSM_STATE), 0.01),
        "ssm_log_dt": jax.random.uniform(ks[10], (DEPTH, SSM_GROUPS), f32, math.log(1e-3), math.log(1e-1)),
        "ssm_b_re": nrm(ks[11], (DEPTH, SSM_GROUPS, SSM_STATE, SSM_GROUP_CH), (2 * SSM_GROUP_CH) ** -0.5),
        "ssm_b_im": nrm(ks[12], (DEPTH, SSM_GROUPS, SSM_STATE, SSM_GROUP_CH), (2 * SSM_GROUP_CH) ** -0.5),
        "ssm_c_re": nrm(ks[13], (DEPTH, SSM_GROUPS, SSM_GROUP_CH, SSM_STATE), (2 * SSM_STATE) ** -0.5),
        "ssm_c_im": nrm(ks[14], (DEPTH, SSM_GROUPS, SSM_GROUP_CH, SSM_STATE), (2 * SSM_STATE) ** -0.5),
        "ssm_d": nrm(ks[15], (DEPTH, SSM_GROUPS, SSM_GROUP_CH), 1.0),
        "w_glu": nrm(ks[16], (DEPTH, SSM_WIDTH, SSM_WIDTH), SSM_WIDTH ** -0.5),
        "b_glu": nrm(ks[17], (DEPTH, SSM_WIDTH), 0.01),
        "g_attn_out": 1.0 + nrm(ks[18], (DEPTH, KV_WIDTH), 0.02),
        "g_ssm_out": 1.0 + nrm(ks[19], (DEPTH, SSM_WIDTH), 0.02),
        "w_out": nrm(ks[20], (DEPTH, OUT_IN_WIDTH, D_MODEL), OUT_IN_WIDTH ** -0.5),
        "g_pre_mlp": 1.0 + nrm(ks[21], (DEPTH, D_MODEL), 0.02),
        "g_post_mlp": 1.0 + nrm(ks[22], (DEPTH, D_MODEL), 0.02),
        "w_mlp_in": nrm(ks[23], (DEPTH, D_MODEL, D_FF), D_MODEL ** -0.5),
        "w_mlp_out": nrm(ks[24], (DEPTH, D_FF, D_MODEL), D_FF ** -0.5),
    }


def reference(x, c, positions, w_ada, b_ada, g_pre_mix, g_post_mix, w_in,
              ssm_a_re, ssm_a_im, ssm_log_dt, ssm_b_re, ssm_b_im, ssm_c_re, ssm_c_im,
              ssm_d, w_glu, b_glu, g_attn_out, g_ssm_out, w_out,
              g_pre_mlp, g_post_mlp, w_mlp_in, w_mlp_out):
    B, L, _ = x.shape
    for l in range(DEPTH):
        mod = jax.nn.silu(c) @ w_ada[l] + b_ada[l]
        sh1, sc1, gt1, sh2, sc2, gt2 = (m[:, None, :] for m in jnp.split(mod, N_MOD, axis=-1))

        h = rms_norm(x, g_pre_mix[l]) * (1.0 + sc1) + sh1
        proj = h @ w_in[l]
        q = proj[..., :ATT_Q_WIDTH].reshape(B, L, N_Q_HEADS, HEAD_DIM)
        k = proj[..., ATT_Q_WIDTH:ATT_Q_WIDTH + KV_WIDTH].reshape(B, L, KV_HEADS, HEAD_DIM)
        v = proj[..., ATT_Q_WIDTH + KV_WIDTH:ATT_Q_WIDTH + 2 * KV_WIDTH].reshape(B, L, KV_HEADS, HEAD_DIM)
        u = proj[..., ATT_Q_WIDTH + 2 * KV_WIDTH:].reshape(B, L, SSM_GROUPS, SSM_GROUP_CH)

        q = rope_partial(q, positions).reshape(B, L, N_ATT_GROUPS, HEADS_PER_GROUP, HEAD_DIM)
        k = rope_partial(k, positions)
        outs, lses = [], []
        for gi, (window, dilation) in enumerate(DILATION_PATTERNS):
            o_g, lse_g = dilated_window_attention(q[:, :, gi], k, v, dilation, window // dilation)
            outs.append(o_g)
            lses.append(lse_g)
        wts = jax.nn.softmax(jnp.stack(lses, axis=0), axis=0)
        att = jnp.sum(wts[..., None].astype(x.dtype) * jnp.stack(outs, axis=0), axis=0)
        att = rms_norm(att.reshape(B, L, KV_WIDTH), g_attn_out[l])

        ssm = s5_mixer(u, ssm_a_re[l], ssm_a_im[l], ssm_log_dt[l], ssm_b_re[l], ssm_b_im[l],
                       ssm_c_re[l], ssm_c_im[l], ssm_d[l], w_glu[l], b_glu[l])
        ssm = rms_norm(ssm, g_ssm_out[l])

        mix = jnp.concatenate([att, ssm], axis=-1) @ w_out[l]
        x = x + gt1 * rms_norm(mix, g_post_mix[l])

        h = rms_norm(x, g_pre_mlp[l]) * (1.0 + sc2) + sh2
        y = jnp.square(jax.nn.relu(h @ w_mlp_in[l])) @ w_mlp_out[l]
        x = x + gt2 * rms_norm(y, g_post_mlp[l])
    return x
```

```cpp
#include <hip/hip_runtime.h>
#include <cstdio>
#include <cstdint>
#include <cmath>
namespace pg8 {
#define PG8_LAS __attribute__((address_space(3)))
typedef unsigned short bf16_t;
typedef short bf16x8 __attribute__((ext_vector_type(8)));
typedef float f32x4 __attribute__((ext_vector_type(4)));
typedef unsigned u32x4 __attribute__((ext_vector_type(4)));
constexpr int BM = 256, BK = 64, HALF = 128, HTB = HALF * BK * 2  , STAGE_BYTES = 8 * HTB, NXCD = 8, WGM = 8;

__host__ __device__ __forceinline__ int lds_byte(int r, int c) { const int st = (r >> 4) * 2 + (c >> 5), rr = r & 15, cc = c & 31, ob = rr * 64 + cc * 2; return st * 1024 + (ob ^ (((ob >> 9) & 1) << 5)); }
__host__ __device__ __forceinline__ void stage_rc(int b, int& R, int& C) { const int st = b / 1024, sb = b % 1024, swz = sb ^ (((sb >> 9) & 1) << 5); R = (st >> 1) * 16 + swz / 64; C = (st & 1) * 32 + (swz % 64) / 2; }
__host__ __device__ __forceinline__ int perm32(int rho) { const int n = rho >> 4, i = rho & 15; return 8 * (i >> 2) + 4 * n + (i & 3); }

struct Unit { int pm, pn; };
struct Gemm { const bf16_t* A; const bf16_t* Bt; int M, N, K; };

struct StaticOrder {
    int nM, nN, nwg, G, c;
    __host__ __device__ void init(int M, int N, int G_, int c_) { nM = M / BM; nN = N / BM; nwg = nM * nN; G = G_; c = c_; }
    __host__ __device__ bool next(int i, Unit& u) const {
        const long L = (long)i * G + c; if (L >= nwg) return false;
        int wgid = (int)L; { const int q = nwg / NXCD, r = nwg % NXCD, xcd = wgid % NXCD, off = wgid / NXCD; wgid = (xcd < r ? xcd * (q + 1) : r * (q + 1) + (xcd - r) * q) + off; }
        const int nig = WGM * nN, gid = wgid / nig, fm = gid * WGM, gsz = (nM - fm) < WGM ? (nM - fm) : WGM;
        u.pm = fm + ((wgid % nig) % gsz); u.pn = (wgid % nig) / gsz; return true;
    }
    __device__ __forceinline__ void a_ready(const Unit&) const {}
    __device__ __forceinline__ void done(const Unit&) const {}
};

__device__ __forceinline__ unsigned cvt_pk_bf16(float lo, float hi) { unsigned r; asm volatile("v_cvt_pk_bf16_f32 %0, %1, %2" : "=v"(r) : "v"(lo), "v"(hi)); return r; }
__device__ __forceinline__ float bf_lo(unsigned w) { return __uint_as_float(w << 16); }
__device__ __forceinline__ float bf_hi(unsigned w) { return __uint_as_float(w & 0xffff0000u); }

template <int ACT  , bool STATS, int MID> struct EpiGen {
    static constexpr bool PERM = true, AFTER_DRAIN = false; static constexpr int MID_T = MID;
    bf16_t* O; int ldc; float* stats; int nstat; const float* midpart; float mid_inv_n, eps;
    __device__ __forceinline__ void mid(f32x4 (&acc)[2][2][4][2], const Unit& u, int wr, int wc, int fr, int fq) const {
        int row0 = u.pm * BM + wr * 64 + fr; asm volatile("" : "+v"(row0));
        const float* mp = midpart + (size_t)row0 * 16 + 4 * fq;
#pragma unroll
        for (int ai = 0; ai < 2; ++ai)
#pragma unroll
            for (int m = 0; m < 4; ++m) { const f32x4 a = *(const f32x4*)(mp + (ai * HALF + m * 16) * 16);
                float ss = (a[0] + a[1]) + (a[2] + a[3]); ss += __shfl_xor(ss, 16); ss += __shfl_xor(ss, 32);
                const float rs = 1.0f / sqrtf(ss * mid_inv_n + eps);
                asm volatile("" ::: "memory");
#pragma unroll
                for (int bj = 0; bj < 2; ++bj)
#pragma unroll
                    for (int n = 0; n < 2; ++n) acc[ai][bj][m][n] = acc[ai][bj][m][n] * rs; }
    }
    __device__ __forceinline__ void operator()(const f32x4 (&acc)[2][2][4][2], const Unit& u, int wr, int wc, int fr, int fq) const {
        const int row0 = u.pm * BM + wr * 64 + fr; const int col0 = u.pn * BM + wc * 32 + 8 * fq;
#pragma unroll
        for (int ai = 0; ai < 2; ++ai)
#pragma unroll
            for (int m = 0; m < 4; ++m) { const int row = row0 + ai * HALF + m * 16; bf16_t* rowp = O + (size_t)row * ldc + col0; float ss = 0.f;
#pragma unroll
                for (int bj = 0; bj < 2; ++bj) { f32x4 v0 = acc[ai][bj][m][0], v1 = acc[ai][bj][m][1];
                    if (ACT == 2) {
#pragma unroll
                        for (int i = 0; i < 4; ++i) { const float a = fmaxf(v0[i], 0.f), b = fmaxf(v1[i], 0.f); v0[i] = a * a; v1[i] = b * b; } }
                    if (STATS) ss += ((v0[0] * v0[0] + v0[1] * v0[1]) + (v0[2] * v0[2] + v0[3] * v0[3])) + ((v1[0] * v1[0] + v1[1] * v1[1]) + (v1[2] * v1[2] + v1[3] * v1[3]));
                    u32x4 w; w.x = cvt_pk_bf16(v0[0], v0[1]); w.y = cvt_pk_bf16(v0[2], v0[3]); w.z = cvt_pk_bf16(v1[0], v1[1]); w.w = cvt_pk_bf16(v1[2], v1[3]);
                    *(u32x4*)(rowp + bj * HALF) = w; }
                if (STATS) { ss += __shfl_xor(ss, 16); ss += __shfl_xor(ss, 32); if (fq == 0) stats[(size_t)row * nstat + u.pn * 4 + wc] = ss; } }
    }
};

struct EpiProj {
    static constexpr bool PERM = true, AFTER_DRAIN = false; static constexpr int MID_T = 0;
    bf16_t* O; const float* rope; float qscale;
    __device__ __forceinline__ void mid(f32x4 (&)[2][2][4][2], const Unit&, int, int, int, int) const {}
    __device__ __forceinline__ void operator()(const f32x4 (&acc)[2][2][4][2], const Unit& u, int wr, int wc, int fr, int fq) const {
        const int row0 = u.pm * BM + wr * 64 + fr; const int col0 = u.pn * BM + wc * 32 + 8 * fq;
        const bool anyrope = (u.pn * BM) < 1536;
        const bool ropelane = (fq < 2) && ((wc & 1) == 0);
#pragma unroll
        for (int ai = 0; ai < 2; ++ai)
#pragma unroll
            for (int m = 0; m < 4; ++m) { const int row = row0 + ai * HALF + m * 16; bf16_t* rowp = O + (size_t)row * 2816 + col0;
                f32x4 c0 = {1.f, 1.f, 1.f, 1.f}, c1 = c0, s0 = {0.f, 0.f, 0.f, 0.f}, s1 = s0;
                if (anyrope) { const f32x4* rp = (const f32x4*)(rope + (size_t)row * 16); c0 = rp[0]; c1 = rp[1]; s0 = rp[2]; s1 = rp[3]; }
#pragma unroll
                for (int bj = 0; bj < 2; ++bj) { const int colb = u.pn * BM + bj * HALF;
                    f32x4 v0 = acc[ai][bj][m][0], v1 = acc[ai][bj][m][1];
                    if (colb < 1536) {
                        f32x4 o0, o1;
#pragma unroll
                        for (int i = 0; i < 4; ++i) { o0[i] = __shfl_xor(v0[i], 16); o1[i] = __shfl_xor(v1[i], 16); }
                        if (ropelane) { if (fq == 0) { v0 = v0 * c0 - o0 * s0; v1 = v1 * c1 - o1 * s1; } else { v0 = v0 * c0 + o0 * s0; v1 = v1 * c1 + o1 * s1; } }
                        if (colb < 1152) { v0 = v0 * qscale; v1 = v1 * qscale; }
                    }
                    u32x4 w; w.x = cvt_pk_bf16(v0[0], v0[1]); w.y = cvt_pk_bf16(v0[2], v0[3]); w.z = cvt_pk_bf16(v1[0], v1[1]); w.w = cvt_pk_bf16(v1[2], v1[3]);
                    *(u32x4*)(rowp + bj * HALF) = w; } }
    }
};

struct EpiGlu {
    static constexpr bool PERM = true, AFTER_DRAIN = false; static constexpr int MID_T = 0;
    bf16_t* O; const bf16_t* Y; const float* bias; float* stats;
    __device__ __forceinline__ void mid(f32x4 (&)[2][2][4][2], const Unit&, int, int, int, int) const {}
    __device__ __forceinline__ void operator()(const f32x4 (&acc)[2][2][4][2], const Unit& u, int wr, int wc, int fr, int fq) const {
        const int row0 = u.pm * BM + wr * 64 + fr; const int col0 = u.pn * BM + wc * 32 + 8 * fq;
        f32x4 bv[2][2];
#pragma unroll
        for (int bj = 0; bj < 2; ++bj)
#pragma unroll
            for (int n = 0; n < 2; ++n) bv[bj][n] = (col0 + bj * HALF < 896) ? *(const f32x4*)(bias + col0 + bj * HALF + 4 * n) : (f32x4){0.f, 0.f, 0.f, 0.f};
#pragma unroll
        for (int ai = 0; ai < 2; ++ai)
#pragma unroll
            for (int m = 0; m < 4; ++m) { const int row = row0 + ai * HALF + m * 16; float ss = 0.f;
#pragma unroll
                for (int bj = 0; bj < 2; ++bj) { const int col = col0 + bj * HALF;
                    if (col < 896) {
                        const f32x4 z0 = acc[ai][bj][m][0] + bv[bj][0], z1 = acc[ai][bj][m][1] + bv[bj][1];
                        const u32x4 yw = *(const u32x4*)(Y + (size_t)row * 896 + col);
                        float y[8] = {bf_lo(yw.x), bf_hi(yw.x), bf_lo(yw.y), bf_hi(yw.y), bf_lo(yw.z), bf_hi(yw.z), bf_lo(yw.w), bf_hi(yw.w)};
                        float s[8];
#pragma unroll
                        for (int i = 0; i < 4; ++i) { s[i] = y[i] / (1.0f + __expf(-z0[i])); s[4 + i] = y[4 + i] / (1.0f + __expf(-z1[i])); }
#pragma unroll
                        for (int i = 0; i < 8; ++i) ss += s[i] * s[i];
                        u32x4 w; w.x = cvt_pk_bf16(s[0], s[1]); w.y = cvt_pk_bf16(s[2], s[3]); w.z = cvt_pk_bf16(s[4], s[5]); w.w = cvt_pk_bf16(s[6], s[7]);
                        *(u32x4*)(O + (size_t)row * 1280 + col) = w; } }
                ss += __shfl_xor(ss, 16); ss += __shfl_xor(ss, 32); if (fq == 0) stats[(size_t)row * 16 + u.pn * 4 + wc] = ss; }
    }
};

template <class Epi, class Sched, bool ALIGN_EPI = false, bool SP2 = false>
__device__ __forceinline__ void gemm_phase(PG8_LAS unsigned char* lds, const Gemm g, const Sched& S, const Epi& E) {
    const int tid = threadIdx.x, wid = __builtin_amdgcn_readfirstlane(tid >> 6), lane = tid & 63, wr = wid >> 2, wc = wid & 3, fr = lane & 15, fq = lane >> 4;
    const int K = g.K, nt = K / BK;
    unsigned voffA[2], voffB[2];
#pragma unroll
    for (int i = 0; i < 2; ++i) { int R, C; stage_rc(tid * 16 + i * 8192, R, C); const int Rb = Epi::PERM ? ((R & ~31) + perm32(R & 31)) : R;
        voffA[i] = (unsigned)(R * K + C) * 2u; voffB[i] = (unsigned)(Rb * K + C) * 2u; }
    const size_t kstep = (size_t)(BK * 2);
    const size_t hstep = (size_t)HALF * K * 2;
    const size_t tstep = 2 * hstep;
    const unsigned ldsw = (unsigned)wid * 1024u;
    const int aoff = lds_byte(wr * 64 + fr, fq * 8), boff = lds_byte(wc * 32 + fr, fq * 8);
#define PG8_SA(b, h) (((b) * 2 + (h)) * HTB)
#define PG8_SB(b, h) ((4 + (b) * 2 + (h)) * HTB)
#define PG8_STAGE(bufoff, gbase, voff) do { _Pragma("unroll") for (int _i = 0; _i < 2; ++_i) \
        __builtin_amdgcn_global_load_lds((const unsigned*)((const char*)(gbase) + (voff)[_i]), (PG8_LAS unsigned*)(lds + (bufoff) + ldsw + _i * 8192), 16, 0, 0); } while (0)
#define PG8_LDA(dst, b, h) do { _Pragma("unroll") for (int m = 0; m < 4; ++m) _Pragma("unroll") for (int k = 0; k < 2; ++k) dst[m][k] = *(const PG8_LAS bf16x8*)(lds + PG8_SA(b, h) + aoff + m * 2048 + k * 1024); } while (0)
#define PG8_LDB(dst, b, h) do { _Pragma("unroll") for (int n = 0; n < 2; ++n) _Pragma("unroll") for (int k = 0; k < 2; ++k) dst[n][k] = *(const PG8_LAS bf16x8*)(lds + PG8_SB(b, h) + boff + n * 2048 + k * 1024); } while (0)
#define PG8_MMA(ai, bj, At, Bt) do { __builtin_amdgcn_s_setprio(1); _Pragma("unroll") for (int m = 0; m < 4; ++m) _Pragma("unroll") for (int n = 0; n < 2; ++n) _Pragma("unroll") for (int k = 0; k < 2; ++k) \
        acc[ai][bj][m][n] = __builtin_amdgcn_mfma_f32_16x16x32_bf16(Bt[n][k], At[m][k], acc[ai][bj][m][n], 0, 0, 0); __builtin_amdgcn_s_setprio(0); } while (0)
#define PG8_WAIT_V(n) asm volatile("s_waitcnt vmcnt(" #n ")" ::: "memory")
#define PG8_WAIT_L(n) asm volatile("s_waitcnt lgkmcnt(" #n ")" ::: "memory")
#define PG8_BAR __builtin_amdgcn_s_barrier()
#define PG8_SCHED __builtin_amdgcn_sched_barrier(0)
    Unit cur, nxt; int ui = 0;
    if (!S.next(0, cur)) return;
    f32x4 acc[2][2][4][2];
#pragma unroll
    for (int a = 0; a < 2; ++a)
#pragma unroll
        for (int b = 0; b < 2; ++b)
#pragma unroll
            for (int m = 0; m < 4; ++m)
#pragma unroll
                for (int n = 0; n < 2; ++n) acc[a][b][m][n] = (f32x4){0.f, 0.f, 0.f, 0.f};
    bf16x8 At[4][2], B0[2][2], B1[2][2];
    const char* cA = (const char*)g.A + (size_t)cur.pm * tstep; const char* cB = (const char*)g.Bt + (size_t)cur.pn * tstep;
    S.a_ready(cur);
    if constexpr (SP2) {
        PG8_STAGE(PG8_SB(0, 0), cB, voffB); PG8_STAGE(PG8_SB(0, 1), cB + hstep, voffB); PG8_STAGE(PG8_SA(0, 0), cA, voffA); PG8_STAGE(PG8_SA(0, 1), cA + hstep, voffA);
        if (wr == 1) PG8_BAR;
        PG8_WAIT_V(2); PG8_BAR;
        PG8_STAGE(PG8_SB(1, 0), cB + kstep, voffB); PG8_STAGE(PG8_SA(1, 0), cA + kstep, voffA); PG8_STAGE(PG8_SB(1, 1), cB + hstep + kstep, voffB);
        PG8_WAIT_V(6); PG8_BAR;
    } else {
        PG8_STAGE(PG8_SB(0, 0), cB, voffB); PG8_STAGE(PG8_SA(0, 0), cA, voffA); PG8_STAGE(PG8_SB(0, 1), cB + hstep, voffB); PG8_STAGE(PG8_SA(0, 1), cA + hstep, voffA);
        if (wr == 1) PG8_BAR;
        PG8_WAIT_V(4); PG8_BAR;
        PG8_STAGE(PG8_SB(1, 0), cB + kstep, voffB); PG8_STAGE(PG8_SA(1, 0), cA + kstep, voffA); PG8_STAGE(PG8_SB(1, 1), cB + hstep + kstep, voffB);
        PG8_WAIT_V(6); PG8_BAR;
    }
    for (;;) {
        const bool has_next = S.next(ui + 1, nxt);
        const char* nA = has_next ? (const char*)g.A + (size_t)nxt.pm * tstep : cA; const char* nB = has_next ? (const char*)g.Bt + (size_t)nxt.pn * tstep : cB;
        for (int t = 0; t < nt; t += 2) {
            if constexpr (Epi::MID_T > 0) { if (t == Epi::MID_T) E.mid(acc, cur, wr, wc, fr, fq); }
            const bool last = (t == nt - 2);
            const char* a1 = cA + (size_t)(t + 1) * kstep;
            const char* a2 = last ? nA : cA + (size_t)(t + 2) * kstep; const char* b2 = last ? nB : cB + (size_t)(t + 2) * kstep;
            const char* a3 = a2 + kstep; const char* b3 = b2 + kstep;
            if (last && has_next) S.a_ready(nxt);
            if constexpr (SP2) {
            PG8_LDB(B0, 0, 0); PG8_LDB(B1, 0, 1); PG8_SCHED; PG8_LDA(At, 0, 0); PG8_STAGE(PG8_SA(1, 1), a1 + hstep, voffA);
            PG8_WAIT_V(8); PG8_WAIT_L(0); PG8_BAR; PG8_MMA(0, 0, At, B0); PG8_MMA(0, 1, At, B1); PG8_BAR; PG8_SCHED;
            PG8_LDA(At, 0, 1); PG8_STAGE(PG8_SB(0, 0), b2, voffB); PG8_STAGE(PG8_SB(0, 1), b2 + hstep, voffB); PG8_STAGE(PG8_SA(0, 0), a2, voffA);
            PG8_WAIT_V(8); PG8_WAIT_L(0); PG8_BAR; PG8_MMA(1, 0, At, B0); PG8_MMA(1, 1, At, B1); PG8_BAR; PG8_SCHED;
            PG8_LDB(B0, 1, 0); PG8_LDB(B1, 1, 1); PG8_SCHED; PG8_LDA(At, 1, 0); PG8_STAGE(PG8_SA(0, 1), a2 + hstep, voffA);
            PG8_WAIT_V(8); PG8_WAIT_L(0); PG8_BAR; PG8_MMA(0, 0, At, B0); PG8_MMA(0, 1, At, B1); PG8_BAR; PG8_SCHED;
            PG8_LDA(At, 1, 1); PG8_STAGE(PG8_SB(1, 0), b3, voffB); PG8_STAGE(PG8_SB(1, 1), b3 + hstep, voffB); PG8_STAGE(PG8_SA(1, 0), a3, voffA);
            PG8_WAIT_V(8); PG8_WAIT_L(0); PG8_BAR; PG8_MMA(1, 0, At, B0); PG8_MMA(1, 1, At, B1); PG8_BAR; PG8_SCHED;
            } else {
            PG8_LDB(B0, 0, 0); PG8_SCHED; PG8_LDA(At, 0, 0); PG8_STAGE(PG8_SA(1, 1), a1 + hstep, voffA);
            PG8_WAIT_L(8); PG8_BAR; PG8_WAIT_L(0); PG8_MMA(0, 0, At, B0); PG8_BAR; PG8_SCHED;
            PG8_LDB(B1, 0, 1); PG8_STAGE(PG8_SB(0, 0), b2, voffB);
            PG8_BAR; PG8_WAIT_L(0); PG8_MMA(0, 1, At, B1); PG8_BAR;
            PG8_LDA(At, 0, 1); PG8_STAGE(PG8_SA(0, 0), a2, voffA);
            PG8_BAR; PG8_WAIT_L(0); PG8_MMA(1, 0, At, B0); PG8_BAR; PG8_SCHED;
            PG8_STAGE(PG8_SB(0, 1), b2 + hstep, voffB);
            PG8_WAIT_V(6); PG8_BAR; PG8_MMA(1, 1, At, B1); PG8_BAR;
            PG8_LDB(B0, 1, 0); PG8_SCHED; PG8_LDA(At, 1, 0); PG8_STAGE(PG8_SA(0, 1), a2 + hstep, voffA);
            PG8_WAIT_L(8); PG8_BAR; PG8_WAIT_L(0); PG8_MMA(0, 0, At, B0); PG8_BAR; PG8_SCHED;
            PG8_LDB(B1, 1, 1); PG8_STAGE(PG8_SB(1, 0), b3, voffB);
            PG8_BAR; PG8_WAIT_L(0); PG8_MMA(0, 1, At, B1); PG8_BAR;
            PG8_LDA(At, 1, 1); PG8_STAGE(PG8_SA(1, 0), a3, voffA);
            PG8_BAR; PG8_WAIT_L(0); PG8_MMA(1, 0, At, B0); PG8_BAR; PG8_SCHED;
            PG8_STAGE(PG8_SB(1, 1), b3 + hstep, voffB);
            PG8_WAIT_V(6); PG8_BAR; PG8_MMA(1, 1, At, B1); PG8_BAR;
            }
        }
        if constexpr (ALIGN_EPI) { if (wr == 0) PG8_BAR; }
        if constexpr (!Epi::AFTER_DRAIN) { E(acc, cur, wr, wc, fr, fq); S.done(cur); }
        if (!has_next) break;
#pragma unroll
        for (int a = 0; a < 2; ++a)
#pragma unroll
            for (int b = 0; b < 2; ++b)
#pragma unroll
                for (int m = 0; m < 4; ++m)
#pragma unroll
                    for (int n = 0; n < 2; ++n) acc[a][b][m][n] = (f32x4){0.f, 0.f, 0.f, 0.f};
        cur = nxt; cA = nA; cB = nB; ++ui;
        if constexpr (ALIGN_EPI) { if (wr == 1) PG8_BAR; }
    }
    PG8_WAIT_V(0);
    if constexpr (!ALIGN_EPI) { if (wr == 0) PG8_BAR; }
    PG8_BAR;
    if constexpr (Epi::AFTER_DRAIN) { E.fused(acc, cur, wr, wc, fr, fq, lds, wid, lane); S.done(cur); }
#undef PG8_SA
#undef PG8_SB
#undef PG8_STAGE
#undef PG8_LDA
#undef PG8_LDB
#undef PG8_MMA
#undef PG8_WAIT_V
#undef PG8_WAIT_L
#undef PG8_BAR
#undef PG8_SCHED
}
}

#ifndef PG8_SP2
#define PG8_SP2 true
#endif
#ifndef PG8_ALIGN
#define PG8_ALIGN true
#endif
#ifndef MK_PER_PHASE
#define MK_PER_PHASE 1
#endif

constexpr int NWAVES = 8;
constexpr int BATCH = 4, SEQ = 4096, M = BATCH * SEQ, D = 2048;
constexpr int NQ = 1152, NKV = 384, NU = 896, NIN = 2816, COL_K = 1152, COL_V = 1536, COL_U = 1920;
constexpr int KOUT = 1280, FF = 8192, NMOD = 6 * D;
constexpr int NG = 56, NST = 64, NCH = 16, LC = 32, NCOL = M / LC;
constexpr int NGLU_PAD = 1024;
constexpr float EPS = 1e-6f;
constexpr float QSCALE = 0.125f * 1.4426950408889634f;
constexpr int N_PHASES = 12;

constexpr size_t MiB = 1u << 20;
constexpr size_t WS_CTL = 0, CTL_ZERO_BYTES = 1 * MiB;
constexpr size_t WS_MOD = 1 * MiB;
constexpr size_t WS_AL = 1 * MiB + 256 * 1024;
constexpr size_t WS_ROPE = 2 * MiB;
constexpr size_t WS_KT = 3 * MiB;
constexpr size_t WS_WET = 4 * MiB;
constexpr size_t WS_G = 11 * MiB;
constexpr size_t WS_WIN = 18 * MiB;
constexpr size_t WS_WGLU = 29 * MiB;
constexpr size_t WS_WOUT = 31 * MiB;
constexpr size_t WS_W1 = 36 * MiB;
constexpr size_t WS_W2 = 68 * MiB;
constexpr size_t WS_H = 100 * MiB;
constexpr size_t WS_MIX = 164 * MiB;
constexpr size_t WS_PGLU = 228 * MiB;
constexpr size_t WS_POUT = 229 * MiB;
constexpr size_t WS_PY2 = 231 * MiB;
constexpr size_t WS_LSE = 234 * MiB;
constexpr size_t WS_PROJ = 236 * MiB;
constexpr size_t WS_E = 324 * MiB;
constexpr size_t WS_CARRY = 338 * MiB;
constexpr size_t WS_OBUF = 345 * MiB;
constexpr size_t WS_YBUF = 381 * MiB;
constexpr size_t WS_AOUT = 409 * MiB;
constexpr size_t WS_HID = 236 * MiB;
constexpr size_t WS_END = 492 * MiB;
static_assert(WS_AOUT + (size_t)M * KOUT * 2 <= WS_END && WS_HID + (size_t)M * FF * 2 <= WS_END, "d_ws map");
constexpr int CW_TMO = 0, CW_CODE = 1, CW_BAR = 4096;

constexpr int RING_OFF = 0, RING_BYTES = 131072;
constexpr int LDSCTL_OFF = RING_BYTES, MISC_OFF = LDSCTL_OFF + 320;
constexpr int LDS_BYTES = 147456;

#define GAS __attribute__((address_space(1)))
#define LAS __attribute__((address_space(3)))
typedef unsigned short bf16;
typedef unsigned v4u __attribute__((ext_vector_type(4)));
typedef float f32x4 __attribute__((ext_vector_type(4)));
typedef short bf16x8 __attribute__((ext_vector_type(8)));
typedef GAS unsigned gu32;
typedef GAS unsigned long long gu64;
#define RLX_AGENT __ATOMIC_RELAXED, __HIP_MEMORY_SCOPE_AGENT
#define LDS_WAIT() asm volatile("s_waitcnt lgkmcnt(0)" ::: "memory")
#define VM_WAIT() asm volatile("s_waitcnt vmcnt(0)" ::: "memory")
__device__ __forceinline__ unsigned long long rt() { return __builtin_amdgcn_s_memrealtime(); }
__device__ __forceinline__ unsigned f2bf(float f) { unsigned u = __builtin_bit_cast(unsigned, f); return (u + 0x7fffu + ((u >> 16) & 1u)) >> 16; }
__device__ __forceinline__ unsigned pk2(float lo, float hi) { return f2bf(lo) | (f2bf(hi) << 16); }

#define XB_TMO      128
#define XB_XCNT(j)  (256  + 64 * (j))
#define XB_XSUB(j)  (1280 + 64 * (j))
#define XB_XGEN(j)  (2304 + 64 * (j))
#define XB_TOP      3328
#define XB_TOPGEN   3392
#define XCD_BAR_WORDS 3456
#define XB_SPIN_CAP (1u << 18)

__device__ __forceinline__ unsigned xb_ld(unsigned* p)              { return __hip_atomic_load(p, __ATOMIC_RELAXED, __HIP_MEMORY_SCOPE_AGENT); }
__device__ __forceinline__ unsigned xb_add(unsigned* p, unsigned v) { return __hip_atomic_fetch_add(p, v, __ATOMIC_RELAXED, __HIP_MEMORY_SCOPE_AGENT); }
__device__ __forceinline__ unsigned xb_xcc_id() { return (unsigned)__builtin_amdgcn_s_getreg((3 << 11) | 20) & 0xFu; }
#define XB_SPIN(cond, bar) do { unsigned _sp = 0; while (cond) { __builtin_amdgcn_s_sleep(1); \
    if ((++_sp & 255u) == 0u) { if (xb_ld(&(bar)[XB_TMO])) break; if (_sp > XB_SPIN_CAP) { atomicAdd(&(bar)[XB_TMO], 1u); break; } } } } while (0)

struct XcdBarrier {
    unsigned* bar; unsigned x;
    volatile LAS unsigned* st;
};

__device__ __forceinline__ XcdBarrier xcd_barrier_post(unsigned* bar, volatile LAS unsigned* st) {
    XcdBarrier b; b.bar = bar; b.x = xb_xcc_id(); b.st = st;
    if (threadIdx.x == 0) (void)xb_add(&bar[XB_XCNT(b.x)], 1u);
    return b;
}
__device__ __forceinline__ void xcd_barrier_complete(unsigned* bar, unsigned x, unsigned& nloc, unsigned& nx) {
    const unsigned G = gridDim.x * gridDim.y * gridDim.z;
    unsigned sum, cnt, mine, sp = 0u;
    for (;;) {
        sum = 0u; cnt = 0u; mine = 0u;
#pragma unroll
        for (unsigned j = 0; j < 16; ++j) { const unsigned c = xb_ld(&bar[XB_XCNT(j)]); sum += c; cnt += (c > 0u) ? 1u : 0u; mine = (j == x) ? c : mine; }
        if (sum == G) break;
        __builtin_amdgcn_s_sleep(1);
        if ((++sp & 255u) == 0u) { if (xb_ld(&bar[XB_TMO])) break; if (sp > XB_SPIN_CAP) { atomicAdd(&bar[XB_TMO], 1u); break; } }
    }
    nloc = mine > 0u ? mine : 1u; nx = cnt > 0u ? cnt : 1u;
}

__device__ __forceinline__ void xcd_barrier(const XcdBarrier& b) {
    asm volatile("s_waitcnt vmcnt(0)" ::: "memory");
    __syncthreads();
    if (threadIdx.x == 0) {
        unsigned* bar = b.bar;
        __builtin_amdgcn_s_waitcnt(0);
        unsigned nloc = b.st[0], nx = b.st[1];
        if (nloc == 0u) { xcd_barrier_complete(bar, b.x, nloc, nx); b.st[0] = nloc; b.st[1] = nx; }
        const unsigned old = xb_add(&bar[XB_XSUB(b.x)], 1u);
        const unsigned gen = old / nloc;
        if (old + 1u == (gen + 1u) * nloc) {
            __builtin_amdgcn_fence(__ATOMIC_RELEASE, "agent");
            asm volatile("s_waitcnt vmcnt(0)" ::: "memory");
            const unsigned og = xb_add(&bar[XB_TOP], 1u);
            const unsigned tg = og / nx;
            if (og + 1u == (tg + 1u) * nx) xb_add(&bar[XB_TOPGEN], 1u);
            else XB_SPIN(xb_ld(&bar[XB_TOPGEN]) == tg, bar);
            __builtin_amdgcn_fence(__ATOMIC_ACQUIRE, "agent");
            xb_add(&bar[XB_XGEN(b.x)], 1u);
            asm volatile("s_waitcnt vmcnt(0)" ::: "memory");
        } else {
            XB_SPIN(xb_ld(&bar[XB_XGEN(b.x)]) == gen, bar);
            __builtin_amdgcn_fence(__ATOMIC_ACQUIRE, "agent");
            asm volatile("s_waitcnt vmcnt(0)" ::: "memory");
        }
    }
    __syncthreads();
}

typedef float f32x16 __attribute__((ext_vector_type(16)));
typedef unsigned u32x4 __attribute__((ext_vector_type(4)));
typedef short s16x4 __attribute__((ext_vector_type(4)));
typedef unsigned u32x2 __attribute__((ext_vector_type(2)));
typedef const float* const __attribute__((address_space(4)))* KARGP;
struct Frame {
    LAS unsigned char* lds;
    volatile LAS unsigned* MISC;
    gu32* ctl;
    int tid, lane, wave;
    int vcu, G;
    KARGP in; float* out; unsigned char* ws;
};
#define IN_X 0
#define IN_C 1
#define IN_POS 2
#define IN_WADA 3
#define IN_BADA 4
#define IN_GPREMIX 5
#define IN_GPOSTMIX 6
#define IN_WIN 7
#define IN_ARE 8
#define IN_AIM 9
#define IN_LOGDT 10
#define IN_BRE 11
#define IN_BIM 12
#define IN_CRE 13
#define IN_CIM 14
#define IN_SSMD 15
#define IN_WGLU 16
#define IN_BGLU 17
#define IN_GATT 18
#define IN_GSSM 19
#define IN_WOUT 20
#define IN_GPREMLP 21
#define IN_GPOSTMLP 22
#define IN_W1 23
#define IN_W2 24

__device__ __forceinline__ float wave_sum(float v) {
#pragma unroll
    for (int o = 1; o < 64; o <<= 1) v += __shfl_xor(v, o);
    return v;
}
__device__ __forceinline__ int crow(int r, int hi) { return (r & 3) + 8 * (r >> 2) + 4 * hi; }


__device__ __forceinline__ void sincos_red(double x, double& s, double& c) {
    double rev = x * 0.15915494309189535; rev -= rint(rev);
    sincospi(2.0 * rev, &s, &c);
}

__device__ __forceinline__ void p0_transpose_item(const float* W, int N, bf16* WT, int ldk, LAS float* scr, int k0, int n0, int kdst, const float* gain, int lane) {
#pragma unroll 8
    for (int i = 0; i < 32; ++i) { const int kk = 2 * i + (lane >> 5); float v = W[(size_t)(k0 + kk) * N + n0 + (lane & 31)]; if (gain) v *= gain[kk]; scr[kk * 33 + (lane & 31)] = v; }
    LDS_WAIT(); asm volatile("" ::: "memory");
    const int c = lane & 7;
#pragma unroll
    for (int j = 0; j < 4; ++j) { const int n = (lane >> 3) + 8 * j; const LAS float* s = scr + (8 * c) * 33 + n;
        v4u o; o.x = pk2(s[0 * 33], s[1 * 33]); o.y = pk2(s[2 * 33], s[3 * 33]); o.z = pk2(s[4 * 33], s[5 * 33]); o.w = pk2(s[6 * 33], s[7 * 33]);
        *(GAS v4u*)(WT + (size_t)(n0 + n) * ldk + kdst + 8 * c) = o; }
    LDS_WAIT(); asm volatile("" ::: "memory");
}

__device__ __forceinline__ void p0_ssm_item(Frame& F, int g, int k) {
    const int n = F.lane;
    const double dt = exp((double)F.in[IN_LOGDT][g]);
    const double lr = (double)F.in[IN_ARE][g * 64 + n], li = (double)F.in[IN_AIM][g * 64 + n];
    const double zr = lr * dt, zi = li * dt;
    double s1, c1; sincos_red(zi, s1, c1);
    const double er = exp(zr), ar = er * c1, ai = er * s1;
    const double den = lr * lr + li * li;
    const double cfr = ((ar - 1.0) * lr + ai * li) / den, cfi = (ai * lr - (ar - 1.0) * li) / den;
    double sk, ck; sincos_red(zi * (double)k, sk, ck);
    const double ek = exp(zr * (double)k), pr_d = ek * ck, pi_d = ek * sk;
    const float pr = (float)pr_d, pi = (float)pi_d;
    bf16* KT = (bf16*)(F.ws + WS_KT); bf16* WET = (bf16*)(F.ws + WS_WET); bf16* GT = (bf16*)(F.ws + WS_G);
    if (k == 32) {
        float* AL = (float*)(F.ws + WS_AL); AL[(g * 64 + n) * 2] = pr; AL[(g * 64 + n) * 2 + 1] = pi;
        unsigned* z = (unsigned*)(KT + (size_t)(g * 33) * 256); z[n] = 0u; z[n + 64] = 0u;
    }
    const float vr = (float)(pr_d * cfr - pi_d * cfi), vi = (float)(pr_d * cfi + pi_d * cfr);
    const float* bre = F.in[IN_BRE] + (size_t)(g * 64 + n) * 16; const float* bim = F.in[IN_BIM] + (size_t)(g * 64 + n) * 16;
    float br[16], bi[16];
#pragma unroll
    for (int q = 0; q < 4; ++q) { const f32x4 a = ((const f32x4*)bre)[q], b = ((const f32x4*)bim)[q];
#pragma unroll
        for (int e = 0; e < 4; ++e) { br[4 * q + e] = a[e]; bi[4 * q + e] = b[e]; } }
    if (k <= 31) {
        const int sg = 31 - k;
        unsigned wre[8], wim[8];
#pragma unroll
        for (int q = 0; q < 8; ++q) { const float r0 = vr * br[2 * q] - vi * bi[2 * q], r1 = vr * br[2 * q + 1] - vi * bi[2 * q + 1];
            const float i0 = vr * bi[2 * q] + vi * br[2 * q], i1 = vr * bi[2 * q + 1] + vi * br[2 * q + 1]; wre[q] = pk2(r0, r1); wim[q] = pk2(i0, i1); }
        v4u* dre = (v4u*)(WET + ((size_t)(g * 128 + n) * 32 + sg) * 16); v4u* dim = (v4u*)(WET + ((size_t)(g * 128 + 64 + n) * 32 + sg) * 16);
        dre[0] = (v4u){wre[0], wre[1], wre[2], wre[3]}; dre[1] = (v4u){wre[4], wre[5], wre[6], wre[7]};
        dim[0] = (v4u){wim[0], wim[1], wim[2], wim[3]}; dim[1] = (v4u){wim[4], wim[5], wim[6], wim[7]};
    }
#pragma unroll 1
    for (int p = 0; p < 16; ++p) {
        const float cr = F.in[IN_CRE][(size_t)(g * 16 + p) * 64 + n], ci = F.in[IN_CIM][(size_t)(g * 16 + p) * 64 + n];
        if (k >= 1) {
            const float gr = cr * pr - ci * pi, gi = -(cr * pi + ci * pr);
            bf16* grow = GT + ((size_t)g * 512 + (k - 1) * 16 + p) * 128;
            grow[n] = (bf16)f2bf(gr); grow[64 + n] = (bf16)f2bf(gi);
        }
        if (k <= 31) {
            const float cvr = cr * vr - ci * vi, cvi = cr * vi + ci * vr;
            float mine = 0.f;
#pragma unroll
            for (int pp = 0; pp < 16; ++pp) { const float t = wave_sum(cvr * br[pp] - cvi * bi[pp]); if (n == pp) mine = t; }
            if (n < 16) { if (k == 0 && n == p) mine += F.in[IN_SSMD][g * 16 + p]; KT[((size_t)(g * 33 + k + 1) * 16 + p) * 16 + n] = (bf16)f2bf(mine); }
        }
    }
}

__device__ __forceinline__ void p1_row(Frame& F, int m) {
    const int b = m >> 12; const float* mod = (const float*)(F.ws + WS_MOD) + (size_t)b * NMOD;
    const GAS f32x4* xr = (const GAS f32x4*)(F.in[IN_X] + (size_t)m * D) + F.lane;
    f32x4 v[8]; float s = 0.f;
#pragma unroll
    for (int j = 0; j < 8; ++j) { v[j] = xr[64 * j]; s += (v[j].x * v[j].x + v[j].y * v[j].y) + (v[j].z * v[j].z + v[j].w * v[j].w); }
    const float rstd = 1.0f / sqrtf(wave_sum(s) * (1.f / D) + EPS);
    GAS unsigned long long* o8 = (GAS unsigned long long*)((bf16*)(F.ws + WS_H) + (size_t)m * D) + F.lane;
#pragma unroll
    for (int j = 0; j < 8; ++j) { const int c = 4 * F.lane + 256 * j;
        const f32x4 g = *(const f32x4*)(F.in[IN_GPREMIX] + c), sh = *(const f32x4*)(mod + c), sc = *(const f32x4*)(mod + D + c);
        const f32x4 h = v[j] * rstd * g * (sc + 1.0f) + sh;
        o8[64 * j] = (unsigned long long)pk2(h.x, h.y) | ((unsigned long long)pk2(h.z, h.w) << 32); }
}

__device__ __forceinline__ void p8_row(Frame& F, int m) {
    const int b = m >> 12; const float* mod = (const float*)(F.ws + WS_MOD) + (size_t)b * NMOD;
    const float* pp = (const float*)(F.ws + WS_POUT) + (size_t)m * 32;
    const float rs_mix = 1.0f / sqrtf(wave_sum(F.lane < 32 ? pp[F.lane] : 0.f) * (1.f / D) + EPS);
    const GAS f32x4* xr = (const GAS f32x4*)(F.in[IN_X] + (size_t)m * D) + F.lane;
    const GAS u32x2* mr = (const GAS u32x2*)((const bf16*)(F.ws + WS_MIX) + (size_t)m * D) + F.lane;
    GAS f32x4* orow = (GAS f32x4*)(F.out + (size_t)m * D) + F.lane;
    f32x4 v[8]; float s = 0.f;
#pragma unroll
    for (int j = 0; j < 8; ++j) { const int c = 4 * F.lane + 256 * j; const u32x2 mw = mr[64 * j];
        const f32x4 mx = {pg8::bf_lo(mw.x), pg8::bf_hi(mw.x), pg8::bf_lo(mw.y), pg8::bf_hi(mw.y)};
        const f32x4 g = *(const f32x4*)(F.in[IN_GPOSTMIX] + c), gt = *(const f32x4*)(mod + 2 * D + c);
        v[j] = xr[64 * j] + gt * (mx * rs_mix * g); orow[64 * j] = v[j];
        s += (v[j].x * v[j].x + v[j].y * v[j].y) + (v[j].z * v[j].z + v[j].w * v[j].w); }
    const float rstd = 1.0f / sqrtf(wave_sum(s) * (1.f / D) + EPS);
    GAS unsigned long long* o8 = (GAS unsigned long long*)((bf16*)(F.ws + WS_H) + (size_t)m * D) + F.lane;
#pragma unroll
    for (int j = 0; j < 8; ++j) { const int c = 4 * F.lane + 256 * j;
        const f32x4 g = *(const f32x4*)(F.in[IN_GPREMLP] + c), sh = *(const f32x4*)(mod + 3 * D + c), sc = *(const f32x4*)(mod + 4 * D + c);
        const f32x4 h = v[j] * rstd * g * (sc + 1.0f) + sh;
        o8[64 * j] = (unsigned long long)pk2(h.x, h.y) | ((unsigned long long)pk2(h.z, h.w) << 32); }
}

__device__ __forceinline__ void p11_row(Frame& F, int m) {
    const int b = m >> 12; const float* mod = (const float*)(F.ws + WS_MOD) + (size_t)b * NMOD;
    const float* pp = (const float*)(F.ws + WS_PY2) + (size_t)m * 32;
    const float rs = 1.0f / sqrtf(wave_sum(F.lane < 32 ? pp[F.lane] : 0.f) * (1.f / D) + EPS);
    const GAS u32x2* yr = (const GAS u32x2*)((const bf16*)(F.ws + WS_MIX) + (size_t)m * D) + F.lane;
    GAS f32x4* orow = (GAS f32x4*)(F.out + (size_t)m * D) + F.lane;
#pragma unroll
    for (int j = 0; j < 8; ++j) { const int c = 4 * F.lane + 256 * j; const u32x2 yw = yr[64 * j];
        const f32x4 y = {pg8::bf_lo(yw.x), pg8::bf_hi(yw.x), pg8::bf_lo(yw.y), pg8::bf_hi(yw.y)};
        const f32x4 g = *(const f32x4*)(F.in[IN_GPOSTMLP] + c), gt = *(const f32x4*)(mod + 5 * D + c);
        orow[64 * j] = orow[64 * j] + gt * (y * rs * g); }
}

constexpr int VPITCH = 192;
__device__ __forceinline__ bf16x8 ld8(const bf16* p) { return *(const bf16x8*)p; }
__device__ __forceinline__ s16x4 vtr(LAS const unsigned char* p) { typedef short v4i16_t __attribute__((ext_vector_type(4))); return __builtin_bit_cast(s16x4, __builtin_amdgcn_ds_read_tr16_b64_v4i16((LAS v4i16_t*)p)); }
__device__ __forceinline__ void attn_wave_unit(Frame& F, int wu) {
    const int lane = F.lane, r32 = lane & 31, hi = lane >> 5;
    const bf16* proj = (const bf16*)(F.ws + WS_PROJ);
    int b = wu / 2304; int rem = wu - b * 2304; const int hh = rem / 384; rem -= hh * 384; const int g = rem >> 7; const int blk = rem & 127;
    const int dsh = 2 * g;
    const int nblk = 128 >> dsh, res = blk / nblk, ib = blk - res * nblk, i0 = ib * 32;
    const size_t rowb = (size_t)b * SEQ;
    const size_t qrow = rowb + ((size_t)(i0 + r32) << dsh) + res;
    const bf16* qp = proj + qrow * NIN + (g * 6 + hh) * 64 + hi * 8;
    bf16x8 qf[4];
#pragma unroll
    for (int kk = 0; kk < 4; ++kk) qf[kk] = ld8(qp + 16 * kk);
    f32x16 S[5];
    const int jmin = (i0 >= 128) ? 0 : (128 - i0) >> 5;
#pragma unroll
    for (int j = 0; j < 5; ++j) {
        S[j] = (f32x16){};
        if (j >= jmin) {
            const int kidx = i0 - 128 + 32 * j + r32;
            const bf16* kp = proj + (rowb + ((size_t)kidx << dsh) + res) * NIN + COL_K + hh * 64 + hi * 8;
            bf16x8 kf[4];
#pragma unroll
            for (int kk = 0; kk < 4; ++kk) kf[kk] = ld8(kp + 16 * kk);
#pragma unroll
            for (int kk = 0; kk < 4; ++kk) S[j] = __builtin_amdgcn_mfma_f32_32x32x16_bf16(kf[kk], qf[kk], S[j], 0, 0, 0);
        }
    }
    const float NEG = -INFINITY;
#pragma unroll
    for (int r = 0; r < 16; ++r) { const int bb = crow(r, hi); if (bb < r32) S[0][r] = NEG; if (bb > r32) S[4][r] = NEG; }
#pragma unroll
    for (int j = 0; j < 4; ++j) if (j < jmin) {
#pragma unroll
        for (int r = 0; r < 16; ++r) S[j][r] = NEG; }
    float mx = NEG;
#pragma unroll
    for (int j = 0; j < 5; ++j)
#pragma unroll
        for (int r = 0; r < 16; ++r) mx = fmaxf(mx, S[j][r]);
    mx = fmaxf(mx, __shfl_xor(mx, 32));
    float l = 0.f;
#pragma unroll
    for (int j = 0; j < 5; ++j)
#pragma unroll
        for (int r = 0; r < 16; ++r) { const float p = __builtin_amdgcn_exp2f(S[j][r] - mx); S[j][r] = p; l += p; }
    l += __shfl_xor(l, 32);
    f32x16 O0 = (f32x16){}, O1 = (f32x16){};
    LAS unsigned char* vl = F.lds + RING_OFF + F.wave * (32 * VPITCH);
    const int grp = lane >> 4;
    const int tr_off = ((grp >> 1) * 4 + ((lane & 15) >> 2)) * VPITCH + ((grp & 1) * 16 + (lane & 3) * 4) * 2;
#pragma unroll
    for (int j = 0; j < 5; ++j) {
        if (j >= jmin) {
            u32x4 vv[4];
#pragma unroll
            for (int i = 0; i < 4; ++i) { const int c = lane + 64 * i, row = c >> 3, ch = c & 7; const int kidx = i0 - 128 + 32 * j + row;
                vv[i] = *(const u32x4*)(proj + (rowb + ((size_t)kidx << dsh) + res) * NIN + COL_V + hh * 64 + ch * 8); }
            asm volatile("s_waitcnt lgkmcnt(0)" ::: "memory");
#pragma unroll
            for (int i = 0; i < 4; ++i) { const int c = lane + 64 * i, row = c >> 3, ch = c & 7; *(LAS u32x4*)(vl + row * VPITCH + ch * 16) = vv[i]; }
            asm volatile("s_waitcnt lgkmcnt(0)" ::: "memory");
#pragma unroll
            for (int s = 0; s < 2; ++s) {
                bf16x8 pf;
#pragma unroll
                for (int e = 0; e < 8; e += 2) { const unsigned w = pg8::cvt_pk_bf16(S[j][8 * s + e], S[j][8 * s + e + 1]); pf[e] = (short)(w & 0xffffu); pf[e + 1] = (short)(w >> 16); }
#pragma unroll
                for (int dt = 0; dt < 2; ++dt) {
                    const s16x4 lo = vtr(vl + tr_off + (16 * s) * VPITCH + dt * 64), hi4 = vtr(vl + tr_off + (16 * s + 8) * VPITCH + dt * 64);
                    const bf16x8 vf = {lo[0], lo[1], lo[2], lo[3], hi4[0], hi4[1], hi4[2], hi4[3]};
                    if (dt == 0) O0 = __builtin_amdgcn_mfma_f32_32x32x16_bf16(vf, pf, O0, 0, 0, 0); else O1 = __builtin_amdgcn_mfma_f32_32x32x16_bf16(vf, pf, O1, 0, 0, 0);
                }
            }
        }
    }
    asm volatile("s_waitcnt lgkmcnt(0)" ::: "memory");
    const float il = 1.0f / l;
    bf16* ob = (bf16*)(F.ws + WS_OBUF) + ((size_t)g * M + qrow) * NKV + hh * 64;
#pragma unroll
    for (int i = 0; i < 4; ++i) {
        u32x2 w0, w1; w0.x = pg8::cvt_pk_bf16(O0[4 * i] * il, O0[4 * i + 1] * il); w0.y = pg8::cvt_pk_bf16(O0[4 * i + 2] * il, O0[4 * i + 3] * il);
        w1.x = pg8::cvt_pk_bf16(O1[4 * i] * il, O1[4 * i + 1] * il); w1.y = pg8::cvt_pk_bf16(O1[4 * i + 2] * il, O1[4 * i + 3] * il);
        *(u32x2*)(ob + 8 * i + 4 * hi) = w0; *(u32x2*)(ob + 32 + 8 * i + 4 * hi) = w1; }
    if (hi == 0) ((float*)(F.ws + WS_LSE))[((size_t)g * M + qrow) * 8 + hh] = mx + __builtin_amdgcn_logf(l);
}

__device__ __forceinline__ void att_combine_row(Frame& F, int m) {
    const float* lse = (const float*)(F.ws + WS_LSE); const bf16* ob = (const bf16*)(F.ws + WS_OBUF);
    float a[6]; float ss = 0.f;
#pragma unroll
    for (int i = 0; i < 6; ++i) {
        const float l0 = lse[((size_t)0 * M + m) * 8 + i], l1 = lse[((size_t)1 * M + m) * 8 + i], l2 = lse[((size_t)2 * M + m) * 8 + i];
        const float mx = fmaxf(l0, fmaxf(l1, l2)); const float w0 = __builtin_amdgcn_exp2f(l0 - mx), w1 = __builtin_amdgcn_exp2f(l1 - mx), w2 = __builtin_amdgcn_exp2f(l2 - mx);
        const float inv = 1.0f / (w0 + w1 + w2);
        const float o0 = __uint_as_float((unsigned)ob[((size_t)0 * M + m) * NKV + 64 * i + F.lane] << 16), o1 = __uint_as_float((unsigned)ob[((size_t)1 * M + m) * NKV + 64 * i + F.lane] << 16),
                    o2 = __uint_as_float((unsigned)ob[((size_t)2 * M + m) * NKV + 64 * i + F.lane] << 16);
        a[i] = (w0 * o0 + w1 * o1 + w2 * o2) * inv; ss += a[i] * a[i]; }
    const float rstd = 1.0f / sqrtf(wave_sum(ss) * (1.f / NKV) + EPS);
    bf16* orow = (bf16*)(F.ws + WS_AOUT) + (size_t)m * KOUT + 896;
#pragma unroll
    for (int i = 0; i < 6; ++i) orow[64 * i + F.lane] = (bf16)f2bf(a[i] * rstd * F.in[IN_GATT][64 * i + F.lane]);
}

__device__ __forceinline__ void ssm_a_unit(Frame& F, int wu) {
    const int lane = F.lane, r32 = lane & 31, hi = lane >> 5;
    const int g = wu >> 6, cb = (wu >> 2) & 15, rt = wu & 3;
    const bf16* proj = (const bf16*)(F.ws + WS_PROJ); const bf16* WET = (const bf16*)(F.ws + WS_WET);
    const int col = cb * 32 + r32;
    const bf16* up = proj + (size_t)col * 32 * NIN + COL_U + g * 16 + hi * 8;
    const bf16* ap = WET + ((size_t)(g * 128 + rt * 32 + r32) * 32) * 16 + hi * 8;
    f32x16 acc = (f32x16){};
#pragma unroll 8
    for (int sg = 0; sg < 32; ++sg) acc = __builtin_amdgcn_mfma_f32_32x32x16_bf16(ld8(ap + sg * 16), ld8(up + (size_t)sg * NIN), acc, 0, 0, 0);
    float* E = (float*)(F.ws + WS_E) + ((size_t)g * NCOL + col) * 128 + rt * 32;
#pragma unroll
    for (int i = 0; i < 4; ++i) *(f32x4*)(E + 8 * i + 4 * hi) = (f32x4){acc[4 * i], acc[4 * i + 1], acc[4 * i + 2], acc[4 * i + 3]};
}
__device__ __forceinline__ void ssm_b_unit(Frame& F, int bg) {
    const int b = bg / NG, g = bg - b * NG, n = F.lane;
    const float* AL = (const float*)(F.ws + WS_AL); const float alr = AL[(g * 64 + n) * 2], ali = AL[(g * 64 + n) * 2 + 1];
    const float* E = (const float*)(F.ws + WS_E) + ((size_t)g * NCOL + b * 128) * 128; bf16* C = (bf16*)(F.ws + WS_CARRY) + ((size_t)g * NCOL + b * 128) * 128;
    float cr = 0.f, ci = 0.f;
#pragma unroll 1
    for (int c0 = 0; c0 < 128; c0 += 16) {
        float er[16], ei[16];
#pragma unroll
        for (int i = 0; i < 16; ++i) { er[i] = E[(size_t)(c0 + i) * 128 + n]; ei[i] = E[(size_t)(c0 + i) * 128 + 64 + n]; }
#pragma unroll
        for (int i = 0; i < 16; ++i) { C[(size_t)(c0 + i) * 128 + n] = (bf16)f2bf(cr); C[(size_t)(c0 + i) * 128 + 64 + n] = (bf16)f2bf(ci);
            const float nr = alr * cr - ali * ci + er[i], ni = alr * ci + ali * cr + ei[i]; cr = nr; ci = ni; }
    }
}
__device__ __forceinline__ float gelu_tanh(float x) { const float u = x * (1.5957691216f + 0.0713548163f * x * x); return x / (1.0f + __expf(-u)); }
__device__ __forceinline__ void ssm_c_unit(Frame& F, int wu) {
    const int lane = F.lane, r32 = lane & 31, hi = lane >> 5;
    const int g = wu >> 7, cb = (wu >> 3) & 15, w = wu & 7;
    const bf16* proj = (const bf16*)(F.ws + WS_PROJ); const bf16* KT = (const bf16*)(F.ws + WS_KT); const bf16* GT = (const bf16*)(F.ws + WS_G);
    const int col = cb * 32 + r32;
    const bf16* up = proj + (size_t)col * 32 * NIN + COL_U + g * 16 + hi * 8;
    const bf16* cp = (const bf16*)(F.ws + WS_CARRY) + ((size_t)g * NCOL + col) * 128 + hi * 8;
    bf16x8 cf[8];
#pragma unroll
    for (int kk = 0; kk < 8; ++kk) cf[kk] = ld8(cp + 16 * kk);
    bf16* yb = (bf16*)(F.ws + WS_YBUF) + (size_t)col * 32 * NU + g * 16;
#pragma unroll 1
    for (int half = 0; half < 2; ++half) {
        const int tau0 = 2 * (half == 0 ? w : 15 - w);
        f32x16 acc = (f32x16){};
        const bf16* gp = GT + ((size_t)g * 512 + tau0 * 16 + r32) * 128 + hi * 8;
#pragma unroll
        for (int kk = 0; kk < 8; ++kk) acc = __builtin_amdgcn_mfma_f32_32x32x16_bf16(ld8(gp + 16 * kk), cf[kk], acc, 0, 0, 0);
        const bf16* kp = KT + ((size_t)(g * 33 + tau0 + 1 + (r32 >> 4)) * 16 + (r32 & 15)) * 16 + hi * 8;
#pragma unroll 2
        for (int sg = 0; sg <= tau0 + 1; ++sg) acc = __builtin_amdgcn_mfma_f32_32x32x16_bf16(ld8(kp - sg * 256), ld8(up + (size_t)sg * NIN), acc, 0, 0, 0);
#pragma unroll
        for (int i = 0; i < 4; ++i) {
            u32x2 o; o.x = pg8::cvt_pk_bf16(gelu_tanh(acc[4 * i]), gelu_tanh(acc[4 * i + 1])); o.y = pg8::cvt_pk_bf16(gelu_tanh(acc[4 * i + 2]), gelu_tanh(acc[4 * i + 3]));
            *(u32x2*)(yb + (size_t)(tau0 + (i >> 1)) * NU + 8 * (i & 1) + 4 * hi) = o; }
    }
}

__device__ __forceinline__ void p0_gemv_item(Frame& F, int item) {
    LAS float* sc = (LAS float*)(F.lds + RING_OFF); LAS float* red = (LAS float*)(F.lds + RING_OFF + 32768);
    const float* W = F.in[IN_WADA]; const int n0 = item * 64;
    const int cg = F.lane & 15, rsub = F.lane >> 4;
    f32x4 acc[4] = {{0.f, 0.f, 0.f, 0.f}, {0.f, 0.f, 0.f, 0.f}, {0.f, 0.f, 0.f, 0.f}, {0.f, 0.f, 0.f, 0.f}};
#pragma unroll 8
    for (int it = 0; it < 64; ++it) { const int k = it * 32 + F.wave * 4 + rsub;
        const f32x4 wv = *(const f32x4*)(W + (size_t)k * NMOD + n0 + 4 * cg);
#pragma unroll
        for (int b = 0; b < 4; ++b) acc[b] = acc[b] + wv * sc[b * D + k]; }
#pragma unroll
    for (int b = 0; b < 4; ++b)
#pragma unroll
        for (int e = 0; e < 4; ++e) { float v = acc[b][e]; v += __shfl_xor(v, 16); v += __shfl_xor(v, 32); acc[b][e] = v; }
    if (rsub == 0) {
#pragma unroll
        for (int b = 0; b < 4; ++b) *(LAS f32x4*)(red + (F.wave * 4 + b) * 64 + 4 * cg) = acc[b]; }
    __syncthreads();
    if (F.tid < 256) { const int b = F.tid >> 6, c = F.tid & 63; float s = F.in[IN_BADA][n0 + c];
#pragma unroll
        for (int w = 0; w < 8; ++w) s += red[(w * 4 + b) * 64 + c];
        ((float*)(F.ws + WS_MOD))[(size_t)b * NMOD + n0 + c] = s; }
    __syncthreads();
}

__device__ __forceinline__ void p0_prologue(Frame& F) {
    constexpr int NGEMV = NMOD / 64;
    if ((int)blockIdx.x < NGEMV) {
        LAS float* sc = (LAS float*)(F.lds + RING_OFF);
        for (int i = F.tid; i < BATCH * D; i += NWAVES * 64) { const float c = F.in[IN_C][i]; sc[i] = c / (1.0f + __expf(-c)); }
        __syncthreads();
        for (int it = blockIdx.x; it < NGEMV; it += F.G) p0_gemv_item(F, it);
    }
    LAS float* scr = (LAS float*)(F.lds + RING_OFF + F.wave * 16384);
    const int gw = F.vcu * NWAVES + F.wave, NGW = F.G * NWAVES;
    for (int it = gw; it < NG * 33; it += NGW) p0_ssm_item(F, it / 33, it % 33);
    constexpr int I_IN = (D / 64) * (NIN / 32), I_GLU = (NU / 64) * (NU / 32), I_OUT = (KOUT / 64) * (D / 32), I_1 = (D / 64) * (FF / 32), I_2 = (FF / 64) * (D / 32), I_ZP = 128;
    constexpr int NITEMS = I_IN + I_GLU + I_OUT + I_1 + I_2 + I_ZP;
    bf16* WIN = (bf16*)(F.ws + WS_WIN); bf16* WGLU = (bf16*)(F.ws + WS_WGLU); bf16* WOUT = (bf16*)(F.ws + WS_WOUT); bf16* W1 = (bf16*)(F.ws + WS_W1); bf16* W2 = (bf16*)(F.ws + WS_W2);
    for (int it = gw; it < NITEMS; it += NGW) {
        int r = it;
        if (r < I_IN) { const int nb = NIN / 32; p0_transpose_item(F.in[IN_WIN], NIN, WIN, D, scr, 64 * (r / nb), 32 * (r % nb), 64 * (r / nb), nullptr, F.lane); continue; } r -= I_IN;
        if (r < I_GLU) { const int nb = NU / 32; p0_transpose_item(F.in[IN_WGLU], NU, WGLU, NU, scr, 64 * (r / nb), 32 * (r % nb), 64 * (r / nb), nullptr, F.lane); continue; } r -= I_GLU;
        if (r < I_OUT) { const int nb = D / 32; const int k0 = 64 * (r / nb);
            p0_transpose_item(F.in[IN_WOUT], D, WOUT, KOUT, scr, k0, 32 * (r % nb), k0 < NKV ? k0 + NU : k0 - NKV, k0 < NKV ? nullptr : F.in[IN_GSSM] + (k0 - NKV), F.lane); continue; } r -= I_OUT;
        if (r < I_1) { const int nb = FF / 32; p0_transpose_item(F.in[IN_W1], FF, W1, D, scr, 64 * (r / nb), 32 * (r % nb), 64 * (r / nb), nullptr, F.lane); continue; } r -= I_1;
        if (r < I_2) { const int nb = D / 32; p0_transpose_item(F.in[IN_W2], D, W2, FF, scr, 64 * (r / nb), 32 * (r % nb), 64 * (r / nb), nullptr, F.lane); continue; } r -= I_2;
        { v4u* z = (v4u*)(WGLU + (size_t)(NU + r) * NU); for (int i = F.lane; i < NU * 2 / 16; i += 64) z[i] = (v4u){0u, 0u, 0u, 0u}; }
    }
    { const int gt = gw * 64 + F.lane, NT = NGW * 64; float* rope = (float*)(F.ws + WS_ROPE); const int* pos = (const int*)F.in[IN_POS];
      for (int it = gt; it < M * 8; it += NT) { const int row = it >> 3, j = it & 7;
          const float f = (float)exp(-(double)j * 0.125 * 13.122363377404328);
          const float ang = (float)pos[row] * f; double s, c; sincos_red((double)ang, s, c);
          rope[row * 16 + j] = (float)c; rope[row * 16 + 8 + j] = (float)s; } }
}

struct Args { const float* in[25]; float* out; unsigned char* ws; int ph_lo, ph_hi, li, pad; };
__global__ void __launch_bounds__(NWAVES * 64, 2) mk_fwd(Args args) {
    extern __shared__ __attribute__((aligned(16))) unsigned char lds[];
    Frame F;
    F.lds = (LAS unsigned char*)lds;
    F.MISC = (volatile LAS unsigned*)(F.lds + MISC_OFF);
    F.tid = threadIdx.x; F.lane = F.tid & 63; F.wave = __builtin_amdgcn_readfirstlane(F.tid >> 6);
    F.G = gridDim.x; { const int bx = blockIdx.x; F.vcu = (F.G % 8 == 0) ? (bx % 8) * (F.G / 8) + bx / 8 : bx; }
    unsigned char* ws = args.ws; F.ws = ws; F.out = args.out;
    F.in = (KARGP)__builtin_amdgcn_kernarg_segment_ptr();
#define RELOAD_IN() asm volatile("" : "+s"(F.in))
    F.ctl = (gu32*)(ws + WS_CTL);
    for (int u = F.tid; u < (LDS_BYTES - LDSCTL_OFF) / 4; u += NWAVES * 64) ((LAS unsigned*)(F.lds + LDSCTL_OFF))[u] = 0u;
    __syncthreads();
    XcdBarrier bar; bar.bar = (unsigned*)(F.ctl + CW_BAR); bar.x = 0; bar.st = nullptr;
    if (!MK_PER_PHASE) bar = xcd_barrier_post((unsigned*)(F.ctl + CW_BAR), F.MISC + 8);
#define GRID_BAR() do { if (MK_PER_PHASE) { if (F.tid == 0) __hip_atomic_store(F.ctl + CW_TMO, 0xBADBA0u, RLX_AGENT); } else { xcd_barrier(bar); } } while (0)
    const int lo = args.ph_lo, hi = args.ph_hi;
#ifndef MK_PHASE_MASK
#define MK_PHASE_MASK 0xFFF
#endif
#define IN(k) (((MK_PHASE_MASK >> (k)) & 1) && lo <= (k) && (k) < hi)
#define BOTH(k) (IN(k) && IN((k) + 1))
    const int gw = F.vcu * NWAVES + F.wave, NGW = F.G * NWAVES;

    if (IN(0)) { RELOAD_IN(); p0_prologue(F); if (BOTH(0)) GRID_BAR(); }
    if (IN(1)) { RELOAD_IN(); for (int m = gw; m < M; m += NGW) p1_row(F, m); if (BOTH(1)) GRID_BAR(); }
    if (IN(2)) { RELOAD_IN();
        pg8::Gemm g{(const pg8::bf16_t*)(ws + WS_H), (const pg8::bf16_t*)(ws + WS_WIN), M, NIN, D}; pg8::StaticOrder S; S.init(M, NIN, F.G, (int)blockIdx.x);
        pg8::EpiProj E{(pg8::bf16_t*)(ws + WS_PROJ), (const float*)(ws + WS_ROPE), QSCALE};
        pg8::gemm_phase<pg8::EpiProj, pg8::StaticOrder, PG8_ALIGN, PG8_SP2>(F.lds + RING_OFF, g, S, E);
        if (BOTH(2)) GRID_BAR();
    }
    if (IN(3)) { RELOAD_IN();
        for (int wu = gw; wu < NG * 64; wu += NGW) ssm_a_unit(F, wu);
        for (int wu = gw; wu < BATCH * 6 * 3 * 128; wu += NGW) attn_wave_unit(F, wu);
        if (BOTH(3)) GRID_BAR();
    }
    if (IN(4)) { RELOAD_IN();
        if (F.wave == 0) for (int bg = F.vcu; bg < BATCH * NG; bg += F.G) ssm_b_unit(F, bg);
        if (BOTH(4)) GRID_BAR();
    }
    if (IN(5)) { RELOAD_IN();
        for (int wu = gw; wu < NG * 128; wu += NGW) ssm_c_unit(F, wu);
        for (int m = gw; m < M; m += NGW) att_combine_row(F, m);
        if (BOTH(5)) GRID_BAR();
    }
    if (IN(6)) { RELOAD_IN();
        pg8::Gemm g{(const pg8::bf16_t*)(ws + WS_YBUF), (const pg8::bf16_t*)(ws + WS_WGLU), M, NGLU_PAD, NU}; pg8::StaticOrder S; S.init(M, NGLU_PAD, F.G, (int)blockIdx.x);
        pg8::EpiGlu E{(pg8::bf16_t*)(ws + WS_AOUT), (const pg8::bf16_t*)(ws + WS_YBUF), F.in[IN_BGLU], (float*)(ws + WS_PGLU)};
        pg8::gemm_phase<pg8::EpiGlu, pg8::StaticOrder, PG8_ALIGN, PG8_SP2>(F.lds + RING_OFF, g, S, E);
        if (BOTH(6)) GRID_BAR();
    }
    if (IN(7)) { RELOAD_IN();
        pg8::Gemm g{(const pg8::bf16_t*)(ws + WS_AOUT), (const pg8::bf16_t*)(ws + WS_WOUT), M, D, KOUT}; pg8::StaticOrder S; S.init(M, D, F.G, (int)blockIdx.x);
        typedef pg8::EpiGen<0, true, 14> Ep; Ep E{(pg8::bf16_t*)(ws + WS_MIX), D, (float*)(ws + WS_POUT), 32, (const float*)(ws + WS_PGLU), 1.0f / NU, EPS};
        pg8::gemm_phase<Ep, pg8::StaticOrder, PG8_ALIGN, PG8_SP2>(F.lds + RING_OFF, g, S, E);
        if (BOTH(7)) GRID_BAR();
    }
    if (IN(8)) { RELOAD_IN(); for (int m = gw; m < M; m += NGW) p8_row(F, m); if (BOTH(8)) GRID_BAR(); }
    if (IN(9)) { RELOAD_IN();
        pg8::Gemm g{(const pg8::bf16_t*)(ws + WS_H), (const pg8::bf16_t*)(ws + WS_W1), M, FF, D}; pg8::StaticOrder S; S.init(M, FF, F.G, (int)blockIdx.x);
        typedef pg8::EpiGen<2, false, 0> Ep; Ep E{(pg8::bf16_t*)(ws + WS_HID), FF, nullptr, 0, nullptr, 0.f, 0.f};
        pg8::gemm_phase<Ep, pg8::StaticOrder, PG8_ALIGN, PG8_SP2>(F.lds + RING_OFF, g, S, E);
        if (BOTH(9)) GRID_BAR();
    }
    if (IN(10)) { RELOAD_IN();
        pg8::Gemm g{(const pg8::bf16_t*)(ws + WS_HID), (const pg8::bf16_t*)(ws + WS_W2), M, D, FF}; pg8::StaticOrder S; S.init(M, D, F.G, (int)blockIdx.x);
        typedef pg8::EpiGen<0, true, 0> Ep; Ep E{(pg8::bf16_t*)(ws + WS_MIX), D, (float*)(ws + WS_PY2), 32, nullptr, 0.f, 0.f};
        pg8::gemm_phase<Ep, pg8::StaticOrder, PG8_ALIGN, PG8_SP2>(F.lds + RING_OFF, g, S, E);
        if (BOTH(10)) GRID_BAR();
    }
    if (IN(11)) { RELOAD_IN(); for (int m = gw; m < M; m += NGW) p11_row(F, m); }
#undef IN
#undef BOTH
}

extern "C" void kernel_launch(void* const* d_in, const int* in_sizes, int n_in, void* d_out, int out_size, void* d_ws, size_t ws_size, hipStream_t stream) {
    static int grid = 0;
    if (grid == 0) {
        if (n_in != 25 || in_sizes[0] != M * D || out_size != M * D || ws_size < WS_END) { fprintf(stderr, "kernel_launch: unexpected shapes: n_in %d in0 %d out %d ws %zu (need %zu)\n", n_in, n_in > 0 ? in_sizes[0] : -1, out_size, ws_size, (size_t)WS_END); grid = -1; return; }
        int dev = 0, cus = 0, per_cu = 0;
        if (hipGetDevice(&dev) != hipSuccess || hipDeviceGetAttribute(&cus, hipDeviceAttributeMultiprocessorCount, dev) != hipSuccess) { fprintf(stderr, "kernel_launch: device query failed\n"); grid = -1; return; }
        if (hipFuncSetAttribute((const void*)mk_fwd, hipFuncAttributeMaxDynamicSharedMemorySize, LDS_BYTES) != hipSuccess) { fprintf(stderr, "kernel_launch: hipFuncSetAttribute failed\n"); grid = -1; return; }
        if (hipOccupancyMaxActiveBlocksPerMultiprocessor(&per_cu, (const void*)mk_fwd, NWAVES * 64, LDS_BYTES) != hipSuccess || per_cu < 1) { fprintf(stderr, "kernel_launch: occupancy query reports %d blocks per CU\n", per_cu); }
        (void)hipGetLastError();
        grid = cus;
    }
    if (grid < 0) return;
    if (hipMemsetAsync((char*)d_ws + WS_CTL, 0, CTL_ZERO_BYTES, stream) != hipSuccess) { fprintf(stderr, "kernel_launch: memset failed\n"); return; }
    Args a{};
    for (int i = 0; i < 25; ++i) a.in[i] = (const float*)d_in[i];
    a.out = (float*)d_out; a.ws = (unsigned char*)d_ws;
#if MK_PER_PHASE
    for (int p = 0; p < N_PHASES; ++p) { a.ph_lo = p; a.ph_hi = p + 1; a.li = p; hipLaunchKernelGGL(mk_fwd, dim3(grid), dim3(NWAVES * 64), LDS_BYTES, stream, a); }
#else
    a.ph_lo = 0; a.ph_hi = N_PHASES; a.li = 0;
    hipLaunchKernelGGL(mk_fwd, dim3(grid), dim3(NWAVES * 64), LDS_BYTES, stream, a);
#endif
    const hipError_t le = hipPeekAtLastError();
    if (le != hipSuccess) fprintf(stderr, "kernel_launch: launch failed: %s\n", hipGetErrorName(le));
}
```

```cpp
#include <hip/hip_runtime.h>
#include <cstdio>
#include <cstdint>
#include <cmath>
#ifndef MK_PRIO
#define MK_PRIO 1
#endif
#ifndef MK_STATICPRIO
#define MK_STATICPRIO 0
#endif
namespace pg8 {
#define PG8_LAS __attribute__((address_space(3)))
typedef unsigned short bf16_t;
typedef short bf16x8 __attribute__((ext_vector_type(8)));
typedef float f32x4 __attribute__((ext_vector_type(4)));
typedef unsigned u32x4 __attribute__((ext_vector_type(4)));
constexpr int BM = 256, BK = 64, HALF = 128, HTB = HALF * BK * 2  , STAGE_BYTES = 8 * HTB, NXCD = 8, WGM = 8;

__host__ __device__ __forceinline__ int lds_byte(int r, int c) { const int st = (r >> 4) * 2 + (c >> 5), rr = r & 15, cc = c & 31, ob = rr * 64 + cc * 2; return st * 1024 + (ob ^ (((ob >> 9) & 1) << 5)); }
__host__ __device__ __forceinline__ void stage_rc(int b, int& R, int& C) { const int st = b / 1024, sb = b % 1024, swz = sb ^ (((sb >> 9) & 1) << 5); R = (st >> 1) * 16 + swz / 64; C = (st & 1) * 32 + (swz % 64) / 2; }
__host__ __device__ __forceinline__ int perm32(int rho) { const int n = rho >> 4, i = rho & 15; return 8 * (i >> 2) + 4 * n + (i & 3); }

struct Unit { int pm, pn; };
struct Gemm { const bf16_t* A; const bf16_t* Bt; int M, N, K; };

struct StaticOrder {
    int nM, nN, nwg, G, c, r0 = 0, nr = 1 << 30, wgm = WGM, rev = 0;
    __host__ __device__ void init(int M, int N, int G_, int c_) { nM = M / BM; nN = N / BM; nwg = nM * nN; G = G_; c = c_; }
    __host__ __device__ bool next(int i, Unit& u) const {
        if (i >= nr) return false;
        const int nrounds = (nwg + G - 1) / G; const int ii = rev ? nrounds - 1 - (i + r0) : i + r0; if (ii < 0) return false;
        const long L = (long)ii * G + c; if (L >= nwg) return false;
        int wgid = (int)L; { const int q = nwg / NXCD, r = nwg % NXCD, xcd = wgid % NXCD, off = wgid / NXCD; wgid = (xcd < r ? xcd * (q + 1) : r * (q + 1) + (xcd - r) * q) + off; }
        const int nig = wgm * nN, gid = wgid / nig, fm = gid * wgm, gsz = (nM - fm) < wgm ? (nM - fm) : wgm;
        u.pm = fm + ((wgid % nig) % gsz); u.pn = (wgid % nig) / gsz; return true;
    }
    __device__ __forceinline__ void a_ready(const Unit&) const {}
    __device__ __forceinline__ void done(const Unit&) const {}
};

__device__ __forceinline__ unsigned cvt_pk_bf16(float lo, float hi) { unsigned r; asm volatile("v_cvt_pk_bf16_f32 %0, %1, %2" : "=v"(r) : "v"(lo), "v"(hi)); return r; }
__device__ __forceinline__ float bf_lo(unsigned w) { return __uint_as_float(w << 16); }
__device__ __forceinline__ float bf_hi(unsigned w) { return __uint_as_float(w & 0xffff0000u); }

template <int ACT  , bool STATS, int MID, int NT = 0  > struct EpiGen {
    static constexpr bool PERM = true, AFTER_DRAIN = false; static constexpr int MID_T = MID;
    bf16_t* O; int ldc; float* stats; int nstat; const float* midpart; float mid_inv_n, eps;
    __device__ __forceinline__ void mid(f32x4 (&acc)[2][2][4][2], const Unit& u, int wr, int wc, int fr, int fq) const {
        int row0 = u.pm * BM + wr * 64 + fr; asm volatile("" : "+v"(row0));
        const float* mp = midpart + (size_t)row0 * 16 + 4 * fq;
#pragma unroll
        for (int ai = 0; ai < 2; ++ai)
#pragma unroll
            for (int m = 0; m < 4; ++m) { const f32x4 a = *(const f32x4*)(mp + (ai * HALF + m * 16) * 16);
                float ss = (a[0] + a[1]) + (a[2] + a[3]); ss += __shfl_xor(ss, 16); ss += __shfl_xor(ss, 32);
                const float rs = 1.0f / sqrtf(ss * mid_inv_n + eps);
                asm volatile("" ::: "memory");
#pragma unroll
                for (int bj = 0; bj < 2; ++bj)
#pragma unroll
                    for (int n = 0; n < 2; ++n) acc[ai][bj][m][n] = acc[ai][bj][m][n] * rs; }
    }
    __device__ __forceinline__ void operator()(const f32x4 (&acc)[2][2][4][2], const Unit& u, int wr, int wc, int fr, int fq) const {
        const int row0 = u.pm * BM + wr * 64 + fr; const int col0 = u.pn * BM + wc * 32 + 8 * fq;
#pragma unroll
        for (int ai = 0; ai < 2; ++ai)
#pragma unroll
            for (int m = 0; m < 4; ++m) { const int row = row0 + ai * HALF + m * 16; bf16_t* rowp = O + (size_t)row * ldc + col0; float ss = 0.f;
#pragma unroll
                for (int bj = 0; bj < 2; ++bj) { f32x4 v0 = acc[ai][bj][m][0], v1 = acc[ai][bj][m][1];
                    if (ACT == 2) {
#pragma unroll
                        for (int i = 0; i < 4; ++i) { const float a = fmaxf(v0[i], 0.f), b = fmaxf(v1[i], 0.f); v0[i] = a * a; v1[i] = b * b; } }
                    if (STATS) ss += ((v0[0] * v0[0] + v0[1] * v0[1]) + (v0[2] * v0[2] + v0[3] * v0[3])) + ((v1[0] * v1[0] + v1[1] * v1[1]) + (v1[2] * v1[2] + v1[3] * v1[3]));
                    u32x4 w; w.x = cvt_pk_bf16(v0[0], v0[1]); w.y = cvt_pk_bf16(v0[2], v0[3]); w.z = cvt_pk_bf16(v1[0], v1[1]); w.w = cvt_pk_bf16(v1[2], v1[3]);
                    if (NT == 1) __builtin_nontemporal_store(w, (u32x4*)(rowp + bj * HALF));
                    else if (NT == 2) { const bf16_t* sp = rowp + bj * HALF; asm volatile("global_store_dwordx4 %0, %1, off sc1\n\ts_nop 1" :: "v"(sp), "v"(w) : "memory"); }
                    else *(u32x4*)(rowp + bj * HALF) = w; }
                if (STATS) { ss += __shfl_xor(ss, 16); ss += __shfl_xor(ss, 32); if (fq == 0) stats[(size_t)row * nstat + u.pn * 4 + wc] = ss; } }
    }
};

struct EpiProj {
    static constexpr bool PERM = true, AFTER_DRAIN = false; static constexpr int MID_T = 0;
    bf16_t* O; const float* rope; float qscale; bf16_t* UT;
    __device__ __forceinline__ void mid(f32x4 (&)[2][2][4][2], const Unit&, int, int, int, int) const {}
    template <int K0, int K1> __device__ __forceinline__ void body(const f32x4 (&acc)[2][2][4][2], const Unit& u, int wr, int wc, int fr, int fq) const {
        const int row0 = u.pm * BM + wr * 64 + fr; const int col0 = u.pn * BM + wc * 32 + 8 * fq;
        constexpr bool anyrope = (K0 < 2) || (K1 < 2);
        const bool ropelane = (fq < 2) && ((wc & 1) == 0);
        const float sg = (fq == 0) ? -1.0f : 1.0f;
#pragma unroll
        for (int am = 0; am < 4; ++am) { const int ai = am >> 1;
            f32x4 rc[4][4];
            if constexpr (anyrope) {
#pragma unroll
                for (int m = 2 * (am & 1); m < 2 * (am & 1) + 2; ++m) { const f32x4* rp = (const f32x4*)(rope + (size_t)(row0 + ai * HALF + m * 16) * 16); rc[m][0] = rp[0]; rc[m][1] = rp[1]; rc[m][2] = rp[2]; rc[m][3] = rp[3]; } }
#pragma unroll
            for (int m = 2 * (am & 1); m < 2 * (am & 1) + 2; ++m) { const int row = row0 + ai * HALF + m * 16; bf16_t* rowp = O + (size_t)row * 2816 + col0;
#pragma unroll
                for (int bj = 0; bj < 2; ++bj) { constexpr int dummy = 0; (void)dummy; const int kind = bj == 0 ? K0 : K1;
                    f32x4 v0 = acc[ai][bj][m][0], v1 = acc[ai][bj][m][1];
                    if (kind < 2) {
                        f32x4 o0, o1;
#pragma unroll
                        for (int i = 0; i < 4; ++i) {
                            const auto ra = __builtin_amdgcn_permlane16_swap(__float_as_uint(v0[i]), __float_as_uint(v0[i]), false, false);
                            const auto rb = __builtin_amdgcn_permlane16_swap(__float_as_uint(v1[i]), __float_as_uint(v1[i]), false, false);
                            o0[i] = __uint_as_float((fq & 1) ? ra[0] : ra[1]); o1[i] = __uint_as_float((fq & 1) ? rb[0] : rb[1]); }
                        const f32x4 r0 = v0 * rc[m][0] + (o0 * rc[m][2]) * sg, r1 = v1 * rc[m][1] + (o1 * rc[m][3]) * sg;
#pragma unroll
                        for (int i = 0; i < 4; ++i) { v0[i] = ropelane ? r0[i] : v0[i]; v1[i] = ropelane ? r1[i] : v1[i]; }
                        if (kind == 0) { v0 = v0 * qscale; v1 = v1 * qscale; }
                    }
                    u32x4 w; w.x = cvt_pk_bf16(v0[0], v0[1]); w.y = cvt_pk_bf16(v0[2], v0[3]); w.z = cvt_pk_bf16(v1[0], v1[1]); w.w = cvt_pk_bf16(v1[2], v1[3]);
                    if (kind < 3) *(u32x4*)(rowp + bj * HALF) = w;
                    else { const int cu = col0 + bj * HALF - 1920; *(u32x4*)(UT + ((size_t)(cu >> 4) * 16384 + row) * 16 + (cu & 15)) = w; } } } }
    }
    __device__ __forceinline__ void operator()(const f32x4 (&acc)[2][2][4][2], const Unit& u, int wr, int wc, int fr, int fq) const {
        if (u.pn < 4) body<0, 0>(acc, u, wr, wc, fr, fq); else if (u.pn == 4) body<0, 1>(acc, u, wr, wc, fr, fq); else if (u.pn == 5) body<1, 1>(acc, u, wr, wc, fr, fq);
        else if (u.pn == 6) body<2, 2>(acc, u, wr, wc, fr, fq); else if (u.pn == 7) body<2, 3>(acc, u, wr, wc, fr, fq); else body<3, 3>(acc, u, wr, wc, fr, fq);
    }
};

struct EpiGlu {
    static constexpr bool PERM = true, AFTER_DRAIN = false; static constexpr int MID_T = 0;
    bf16_t* O; const bf16_t* Y; const float* bias; float* stats;
    __device__ __forceinline__ void mid(f32x4 (&)[2][2][4][2], const Unit&, int, int, int, int) const {}
    template <int NBJ> __device__ __forceinline__ void body(const f32x4 (&acc)[2][2][4][2], const Unit& u, int wr, int wc, int fr, int fq) const {
        const int row0 = u.pm * BM + wr * 64 + fr; const int col0 = u.pn * BM + wc * 32 + 8 * fq;
        f32x4 bv[NBJ][2]; u32x4 yv[2][4][NBJ];
#pragma unroll
        for (int bj = 0; bj < NBJ; ++bj)
#pragma unroll
            for (int n = 0; n < 2; ++n) bv[bj][n] = *(const f32x4*)(bias + col0 + bj * HALF + 4 * n);
#pragma unroll
        for (int ai = 0; ai < 2; ++ai)
#pragma unroll
            for (int m = 0; m < 4; ++m)
#pragma unroll
                for (int bj = 0; bj < NBJ; ++bj) yv[ai][m][bj] = *(const u32x4*)(Y + (size_t)(row0 + ai * HALF + m * 16) * 896 + col0 + bj * HALF);
#pragma unroll
        for (int ai = 0; ai < 2; ++ai)
#pragma unroll
            for (int m = 0; m < 4; ++m) { const int row = row0 + ai * HALF + m * 16; float ss = 0.f;
#pragma unroll
                for (int bj = 0; bj < NBJ; ++bj) { const int col = col0 + bj * HALF;
                    const f32x4 z0 = acc[ai][bj][m][0] + bv[bj][0], z1 = acc[ai][bj][m][1] + bv[bj][1];
                    const u32x4 yw = yv[ai][m][bj];
                    float y[8] = {bf_lo(yw.x), bf_hi(yw.x), bf_lo(yw.y), bf_hi(yw.y), bf_lo(yw.z), bf_hi(yw.z), bf_lo(yw.w), bf_hi(yw.w)};
                    float s[8];
#pragma unroll
                    for (int i = 0; i < 4; ++i) { s[i] = y[i] * __builtin_amdgcn_rcpf(1.0f + __builtin_amdgcn_exp2f(-1.4426950408889634f * z0[i])); s[4 + i] = y[4 + i] * __builtin_amdgcn_rcpf(1.0f + __builtin_amdgcn_exp2f(-1.4426950408889634f * z1[i])); }
#pragma unroll
                    for (int i = 0; i < 8; ++i) ss += s[i] * s[i];
                    u32x4 w; w.x = cvt_pk_bf16(s[0], s[1]); w.y = cvt_pk_bf16(s[2], s[3]); w.z = cvt_pk_bf16(s[4], s[5]); w.w = cvt_pk_bf16(s[6], s[7]);
                    *(u32x4*)(O + (size_t)row * 1280 + col) = w; }
                ss += __shfl_xor(ss, 16); ss += __shfl_xor(ss, 32); if (fq == 0) stats[(size_t)row * 16 + u.pn * 4 + wc] = ss; }
    }
    __device__ __forceinline__ void operator()(const f32x4 (&acc)[2][2][4][2], const Unit& u, int wr, int wc, int fr, int fq) const {
        if (u.pn < 3) body<2>(acc, u, wr, wc, fr, fq); else body<1>(acc, u, wr, wc, fr, fq);
    }
};

template <class Epi, class Sched, bool ALIGN_EPI = false, bool SP2 = false, int PROBE = 0  , int AUXA = 0  >
__device__ __forceinline__ void gemm_phase(PG8_LAS unsigned char* lds, const Gemm g, const Sched& S, const Epi& E) {
    const int tid = threadIdx.x, wid = __builtin_amdgcn_readfirstlane(tid >> 6), lane = tid & 63, wr = wid >> 2, wc = wid & 3, fr = lane & 15, fq = lane >> 4;
    const int K = g.K, nt = K / BK;
    unsigned voffA[2], voffB[2];
#pragma unroll
    for (int i = 0; i < 2; ++i) { int R, C; stage_rc(tid * 16 + i * 8192, R, C); const int Rb = Epi::PERM ? ((R & ~31) + perm32(R & 31)) : R;
        voffA[i] = (unsigned)(R * K + C) * 2u; voffB[i] = (unsigned)(Rb * K + C) * 2u; }
    const size_t kstep = (size_t)(BK * 2);
    const size_t hstep = (size_t)HALF * K * 2;
    const size_t tstep = 2 * hstep;
    const unsigned ldsw = (unsigned)wid * 1024u;
    const int aoff = lds_byte(wr * 64 + fr, fq * 8), boff = lds_byte(wc * 32 + fr, fq * 8);
#define PG8_SA(b, h) (((b) * 2 + (h)) * HTB)
#define PG8_SB(b, h) ((4 + (b) * 2 + (h)) * HTB)
#define PG8_STAGE(bufoff, gbase, voff) do { if (!(PROBE & 2)) _Pragma("unroll") for (int _i = 0; _i < 2; ++_i) \
        __builtin_amdgcn_global_load_lds((const unsigned*)((const char*)(gbase) + (voff)[_i]), (PG8_LAS unsigned*)(lds + (bufoff) + ldsw + _i * 8192), 16, 0, 0); } while (0)
#define PG8_STAGEA(bufoff, gbase, voff) do { if (!(PROBE & 2)) _Pragma("unroll") for (int _i = 0; _i < 2; ++_i) \
        __builtin_amdgcn_global_load_lds((const unsigned*)((const char*)(gbase) + (voff)[_i]), (PG8_LAS unsigned*)(lds + (bufoff) + ldsw + _i * 8192), 16, 0, AUXA); } while (0)
#define PG8_LDA(dst, b, h) do { if (!(PROBE & 8)) _Pragma("unroll") for (int m = 0; m < 4; ++m) _Pragma("unroll") for (int k = 0; k < 2; ++k) dst[m][k] = *(const PG8_LAS bf16x8*)(lds + PG8_SA(b, h) + aoff + m * 2048 + k * 1024); } while (0)
#define PG8_LDB(dst, b, h) do { if (!(PROBE & 8)) _Pragma("unroll") for (int n = 0; n < 2; ++n) _Pragma("unroll") for (int k = 0; k < 2; ++k) dst[n][k] = *(const PG8_LAS bf16x8*)(lds + PG8_SB(b, h) + boff + n * 2048 + k * 1024); } while (0)
#define PG8_MMA(ai, bj, At, Bt) do { if (!MK_STATICPRIO) __builtin_amdgcn_s_setprio(MK_PRIO); if (!(PROBE & 1)) _Pragma("unroll") for (int m = 0; m < 4; ++m) _Pragma("unroll") for (int n = 0; n < 2; ++n) _Pragma("unroll") for (int k = 0; k < 2; ++k) \
        acc[ai][bj][m][n] = __builtin_amdgcn_mfma_f32_16x16x32_bf16(Bt[n][k], At[m][k], acc[ai][bj][m][n], 0, 0, 0); if (!MK_STATICPRIO) __builtin_amdgcn_s_setprio(0); } while (0)
#define PG8_WAIT_V(n) asm volatile("s_waitcnt vmcnt(" #n ")" ::: "memory")
#define PG8_WAIT_L(n) asm volatile("s_waitcnt lgkmcnt(" #n ")" ::: "memory")
#define PG8_BAR __builtin_amdgcn_s_barrier()
#define PG8_SCHED __builtin_amdgcn_sched_barrier(0)
    Unit cur, nxt; int ui = 0;
    if (!S.next(0, cur)) return;
    if (MK_STATICPRIO) { if (wid >= 4) __builtin_amdgcn_s_setprio(1); }
    f32x4 acc[2][2][4][2];
#pragma unroll
    for (int a = 0; a < 2; ++a)
#pragma unroll
        for (int b = 0; b < 2; ++b)
#pragma unroll
            for (int m = 0; m < 4; ++m)
#pragma unroll
                for (int n = 0; n < 2; ++n) acc[a][b][m][n] = (f32x4){0.f, 0.f, 0.f, 0.f};
    bf16x8 At[4][2], B0[2][2], B1[2][2];
    if constexpr ((PROBE & 8) != 0) {
#pragma unroll
        for (int m = 0; m < 4; ++m)
#pragma unroll
            for (int k = 0; k < 2; ++k) asm volatile("" : "=v"(At[m][k]));
#pragma unroll
        for (int n = 0; n < 2; ++n)
#pragma unroll
            for (int k = 0; k < 2; ++k) { asm volatile("" : "=v"(B0[n][k])); asm volatile("" : "=v"(B1[n][k])); } }
    const char* cA = (const char*)g.A + (size_t)((PROBE & 16) ? 0 : cur.pm) * tstep; const char* cB = (const char*)g.Bt + (size_t)((PROBE & 16) ? 0 : cur.pn) * tstep;
    S.a_ready(cur);
    if constexpr (SP2) {
        PG8_STAGE(PG8_SB(0, 0), cB, voffB); PG8_STAGE(PG8_SB(0, 1), cB + hstep, voffB); PG8_STAGEA(PG8_SA(0, 0), cA, voffA); PG8_STAGEA(PG8_SA(0, 1), cA + hstep, voffA);
        if (wr == 1) PG8_BAR;
        PG8_WAIT_V(2); PG8_BAR;
        PG8_STAGE(PG8_SB(1, 0), cB + kstep, voffB); PG8_STAGEA(PG8_SA(1, 0), cA + kstep, voffA); PG8_STAGE(PG8_SB(1, 1), cB + hstep + kstep, voffB);
        PG8_WAIT_V(6); PG8_BAR;
    } else {
        PG8_STAGE(PG8_SB(0, 0), cB, voffB); PG8_STAGEA(PG8_SA(0, 0), cA, voffA); PG8_STAGE(PG8_SB(0, 1), cB + hstep, voffB); PG8_STAGEA(PG8_SA(0, 1), cA + hstep, voffA);
        if (wr == 1) PG8_BAR;
        PG8_WAIT_V(4); PG8_BAR;
        PG8_STAGE(PG8_SB(1, 0), cB + kstep, voffB); PG8_STAGEA(PG8_SA(1, 0), cA + kstep, voffA); PG8_STAGE(PG8_SB(1, 1), cB + hstep + kstep, voffB);
        PG8_WAIT_V(6); PG8_BAR;
    }
    for (;;) {
        const bool has_next = S.next(ui + 1, nxt);
        const char* nA = (has_next && !(PROBE & 16)) ? (const char*)g.A + (size_t)nxt.pm * tstep : cA; const char* nB = (has_next && !(PROBE & 16)) ? (const char*)g.Bt + (size_t)nxt.pn * tstep : cB;
        for (int t = 0; t < nt; t += 2) {
            if constexpr (Epi::MID_T > 0) { if (t == Epi::MID_T) E.mid(acc, cur, wr, wc, fr, fq); }
            const bool last = (t == nt - 2);
            const char* a1 = cA + (size_t)(t + 1) * kstep;
            const char* a2 = last ? nA : cA + (size_t)(t + 2) * kstep; const char* b2 = last ? nB : cB + (size_t)(t + 2) * kstep;
            const char* a3 = a2 + kstep; const char* b3 = b2 + kstep;
            if (last && has_next) S.a_ready(nxt);
            if constexpr (SP2) {
            PG8_LDB(B0, 0, 0); PG8_LDB(B1, 0, 1); PG8_SCHED; PG8_LDA(At, 0, 0); PG8_STAGEA(PG8_SA(1, 1), a1 + hstep, voffA);
            PG8_WAIT_V(8); PG8_WAIT_L(0); PG8_BAR; PG8_MMA(0, 0, At, B0); PG8_MMA(0, 1, At, B1); PG8_BAR; PG8_SCHED;
            PG8_LDA(At, 0, 1); PG8_STAGE(PG8_SB(0, 0), b2, voffB); PG8_STAGE(PG8_SB(0, 1), b2 + hstep, voffB); PG8_STAGEA(PG8_SA(0, 0), a2, voffA);
            PG8_WAIT_V(8); PG8_WAIT_L(0); PG8_BAR; PG8_MMA(1, 0, At, B0); PG8_MMA(1, 1, At, B1); PG8_BAR; PG8_SCHED;
            PG8_LDB(B0, 1, 0); PG8_LDB(B1, 1, 1); PG8_SCHED; PG8_LDA(At, 1, 0); PG8_STAGEA(PG8_SA(0, 1), a2 + hstep, voffA);
            PG8_WAIT_V(8); PG8_WAIT_L(0); PG8_BAR; PG8_MMA(0, 0, At, B0); PG8_MMA(0, 1, At, B1); PG8_BAR; PG8_SCHED;
            PG8_LDA(At, 1, 1); PG8_STAGE(PG8_SB(1, 0), b3, voffB); PG8_STAGE(PG8_SB(1, 1), b3 + hstep, voffB); PG8_STAGEA(PG8_SA(1, 0), a3, voffA);
            PG8_WAIT_V(8); PG8_WAIT_L(0); PG8_BAR; PG8_MMA(1, 0, At, B0); PG8_MMA(1, 1, At, B1); PG8_BAR; PG8_SCHED;
            } else {
            PG8_LDB(B0, 0, 0); PG8_SCHED; PG8_LDA(At, 0, 0); PG8_STAGEA(PG8_SA(1, 1), a1 + hstep, voffA);
            PG8_WAIT_L(8); PG8_BAR; PG8_WAIT_L(0); PG8_MMA(0, 0, At, B0); PG8_BAR; PG8_SCHED;
            PG8_LDB(B1, 0, 1); PG8_STAGE(PG8_SB(0, 0), b2, voffB);
            PG8_BAR; PG8_WAIT_L(0); PG8_MMA(0, 1, At, B1); PG8_BAR;
            PG8_LDA(At, 0, 1); PG8_STAGEA(PG8_SA(0, 0), a2, voffA);
            PG8_BAR; PG8_WAIT_L(0); PG8_MMA(1, 0, At, B0); PG8_BAR; PG8_SCHED;
            PG8_STAGE(PG8_SB(0, 1), b2 + hstep, voffB);
            PG8_WAIT_V(6); PG8_BAR; PG8_MMA(1, 1, At, B1); PG8_BAR;
            PG8_LDB(B0, 1, 0); PG8_SCHED; PG8_LDA(At, 1, 0); PG8_STAGEA(PG8_SA(0, 1), a2 + hstep, voffA);
            PG8_WAIT_L(8); PG8_BAR; PG8_WAIT_L(0); PG8_MMA(0, 0, At, B0); PG8_BAR; PG8_SCHED;
            PG8_LDB(B1, 1, 1); PG8_STAGE(PG8_SB(1, 0), b3, voffB);
            PG8_BAR; PG8_WAIT_L(0); PG8_MMA(0, 1, At, B1); PG8_BAR;
            PG8_LDA(At, 1, 1); PG8_STAGEA(PG8_SA(1, 0), a3, voffA);
            PG8_BAR; PG8_WAIT_L(0); PG8_MMA(1, 0, At, B0); PG8_BAR; PG8_SCHED;
            PG8_STAGE(PG8_SB(1, 1), b3 + hstep, voffB);
            PG8_WAIT_V(6); PG8_BAR; PG8_MMA(1, 1, At, B1); PG8_BAR;
            }
        }
        if constexpr (ALIGN_EPI) { if (wr == 0) PG8_BAR; }
        if constexpr (!Epi::AFTER_DRAIN) { if constexpr (PROBE & 4) { _Pragma("unroll") for (int a_ = 0; a_ < 2; ++a_) _Pragma("unroll") for (int b_ = 0; b_ < 2; ++b_) _Pragma("unroll") for (int m_ = 0; m_ < 4; ++m_) _Pragma("unroll") for (int n_ = 0; n_ < 2; ++n_) asm volatile("" :: "v"(acc[a_][b_][m_][n_])); } else { E(acc, cur, wr, wc, fr, fq); } S.done(cur); }
        if (!has_next) break;
#pragma unroll
        for (int a = 0; a < 2; ++a)
#pragma unroll
            for (int b = 0; b < 2; ++b)
#pragma unroll
                for (int m = 0; m < 4; ++m)
#pragma unroll
                    for (int n = 0; n < 2; ++n) acc[a][b][m][n] = (f32x4){0.f, 0.f, 0.f, 0.f};
        cur = nxt; cA = nA; cB = nB; ++ui;
        if constexpr (ALIGN_EPI) { if (wr == 1) PG8_BAR; }
    }
    if (MK_STATICPRIO) __builtin_amdgcn_s_setprio(0);
    PG8_WAIT_V(0);
    if constexpr (!ALIGN_EPI) { if (wr == 0) PG8_BAR; }
    PG8_BAR;
    if constexpr (Epi::AFTER_DRAIN) { E.fused(acc, cur, wr, wc, fr, fq, lds, wid, lane); S.done(cur); }
#undef PG8_SA
#undef PG8_SB
#undef PG8_STAGE
#undef PG8_STAGEA
#undef PG8_LDA
#undef PG8_LDB
#undef PG8_MMA
#undef PG8_WAIT_V
#undef PG8_WAIT_L
#undef PG8_BAR
#undef PG8_SCHED
}
}

#ifndef PG8_SP2
#define PG8_SP2 true
#endif
#ifndef PG8_ALIGN
#define PG8_ALIGN true
#endif
#ifndef MK_PER_PHASE
#define MK_PER_PHASE 0
#endif

#ifndef MK_P0SUB
#define MK_P0SUB 0
#endif
#ifndef MK_P0MODE
#define MK_P0MODE 7
#endif
#ifndef MK_SUB
#define MK_SUB 0
#endif
#ifndef MK_CMODE
#define MK_CMODE 7
#endif
#ifndef MK_GPROBE
#define MK_GPROBE 0
#endif
#ifndef MK_NT9
#define MK_NT9 0
#endif
#ifndef MK_W1TAIL
#define MK_W1TAIL 4096
#endif
#ifndef MK_AMODE
#define MK_AMODE 15
#endif
#ifndef MK_P1G
#define MK_P1G 53
#endif
#ifndef MK_NTLD
#define MK_NTLD 3
#endif
#ifndef MK_AUX10
#define MK_AUX10 0
#endif
#ifndef MK_WGM10
#define MK_WGM10 4
#endif
#ifndef MK_WGM9
#define MK_WGM9 4
#endif
#ifndef MK_WGM7
#define MK_WGM7 4
#endif
#ifndef MK_WGM2
#define MK_WGM2 4
#endif
#ifndef MK_REV10
#define MK_REV10 1
#endif
#ifndef MK_P1BAL
#define MK_P1BAL 0
#endif
#ifndef MK_SSMTAIL
#define MK_SSMTAIL 0
#endif
#ifndef MK_DUP
#define MK_DUP -1
#endif

constexpr int NWAVES = 8;
constexpr int BATCH = 4, SEQ = 4096, M = BATCH * SEQ, D = 2048;
constexpr int NQ = 1152, NKV = 384, NU = 896, NIN = 2816, COL_K = 1152, COL_V = 1536, COL_U = 1920;
constexpr int KOUT = 1280, FF = 8192, NMOD = 6 * D;
constexpr int NG = 56, NST = 64, NCH = 16, LC = 32, NCOL = M / LC;
constexpr int NGLU_PAD = 1024;
constexpr float EPS = 1e-6f;
constexpr float QSCALE = 0.125f * 1.4426950408889634f;
constexpr int N_PHASES = 12;

constexpr size_t MiB = 1u << 20;
constexpr size_t WS_CTL = 0, CTL_ZERO_BYTES = 32 * 1024;
constexpr size_t WS_MOD = 1 * MiB;
constexpr size_t WS_AL = 1 * MiB + 256 * 1024;
constexpr size_t WS_ROPE = 2 * MiB;
constexpr size_t WS_KT = 3 * MiB;
constexpr size_t WS_WET = 4 * MiB;
constexpr size_t WS_G = 11 * MiB;
constexpr size_t WS_WIN = 18 * MiB;
constexpr size_t WS_WGLU = 29 * MiB;
constexpr size_t WS_WOUT = 31 * MiB;
constexpr size_t WS_W1 = 36 * MiB;
constexpr size_t WS_W2 = 68 * MiB;
constexpr size_t WS_H = 448 * MiB;
constexpr size_t WS_MIX = 384 * MiB;
constexpr size_t WS_PGLU = 356 * MiB;
constexpr size_t WS_POUT = 357 * MiB;
constexpr size_t WS_PY2 = 359 * MiB;
constexpr size_t WS_LSE = 320 * MiB;
constexpr size_t WS_PROJ = 100 * MiB;
constexpr size_t WS_E = 362 * MiB;
constexpr size_t WS_CARRY = 362 * MiB;
constexpr size_t WS_OBUF = 216 * MiB;
constexpr size_t WS_YBUF = 252 * MiB;
constexpr size_t WS_AOUT = 280 * MiB;
constexpr size_t WS_UT = 188 * MiB;
constexpr size_t WS_HID = 100 * MiB;
constexpr size_t WS_END = 512 * MiB;
static_assert(WS_PROJ + (size_t)M * NIN * 2 <= WS_UT && WS_UT + (size_t)M * NU * 2 <= WS_OBUF && WS_OBUF + (size_t)3 * M * NKV * 2 <= WS_YBUF && WS_YBUF + (size_t)M * NU * 2 <= WS_AOUT && WS_AOUT + (size_t)M * KOUT * 2 <= WS_LSE &&
              WS_LSE + (size_t)3 * M * 8 * 4 <= WS_PGLU && WS_HID + (size_t)M * FF * 2 <= WS_PGLU && WS_PY2 + (size_t)M * 32 * 4 <= WS_MIX && WS_MIX + (size_t)M * D * 2 <= WS_H && WS_H + (size_t)M * D * 2 <= WS_END && WS_W2 + (size_t)D * FF * 2 <= WS_HID, "d_ws map");
constexpr int CW_TMO = 0, CW_CODE = 1, CW_GEMV = 64, CW_BAR = 4096;
static_assert((CW_BAR + 3456) * 4 <= (int)CTL_ZERO_BYTES, "control words inside the memset region");

constexpr int LDS_BYTES_C = 147456;
constexpr int RING_OFF = 0, RING_BYTES = 131072;
constexpr int LDSCTL_OFF = 8 * 16640  , MISC_OFF = LDSCTL_OFF + 320;
static_assert(LDSCTL_OFF >= RING_BYTES && MISC_OFF + 128 <= LDS_BYTES_C, "LDS map");
constexpr int LDS_BYTES = 147456;

#define GAS __attribute__((address_space(1)))
#define LAS __attribute__((address_space(3)))
typedef unsigned short bf16;
typedef unsigned v4u __attribute__((ext_vector_type(4)));
typedef float f32x4 __attribute__((ext_vector_type(4)));
typedef short bf16x8 __attribute__((ext_vector_type(8)));
typedef GAS unsigned gu32;
typedef GAS unsigned long long gu64;
#define RLX_AGENT __ATOMIC_RELAXED, __HIP_MEMORY_SCOPE_AGENT
#define LDS_WAIT() asm volatile("s_waitcnt lgkmcnt(0)" ::: "memory")
#define VM_WAIT() asm volatile("s_waitcnt vmcnt(0)" ::: "memory")
__device__ __forceinline__ unsigned long long rt() { return __builtin_amdgcn_s_memrealtime(); }
__device__ __forceinline__ unsigned f2bf(float f) { unsigned u = __builtin_bit_cast(unsigned, f); return (u + 0x7fffu + ((u >> 16) & 1u)) >> 16; }
__device__ __forceinline__ unsigned pk2(float lo, float hi) { return f2bf(lo) | (f2bf(hi) << 16); }

#define XB_TMO      128
#define XB_XCNT(j)  (256  + 64 * (j))
#define XB_XSUB(j)  (1280 + 64 * (j))
#define XB_XGEN(j)  (2304 + 64 * (j))
#define XB_TOP      3328
#define XB_TOPGEN   3392
#define XCD_BAR_WORDS 3456
#define XB_SPIN_CAP (1u << 18)

__device__ __forceinline__ unsigned xb_ld(unsigned* p)              { return __hip_atomic_load(p, __ATOMIC_RELAXED, __HIP_MEMORY_SCOPE_AGENT); }
__device__ __forceinline__ unsigned xb_add(unsigned* p, unsigned v) { return __hip_atomic_fetch_add(p, v, __ATOMIC_RELAXED, __HIP_MEMORY_SCOPE_AGENT); }
__device__ __forceinline__ unsigned xb_xcc_id() { return (unsigned)__builtin_amdgcn_s_getreg((3 << 11) | 20) & 0xFu; }
#define XB_SPIN(cond, bar) do { unsigned _sp = 0; while (cond) { __builtin_amdgcn_s_sleep(1); \
    if ((++_sp & 255u) == 0u) { if (xb_ld(&(bar)[XB_TMO])) break; if (_sp > XB_SPIN_CAP) { atomicAdd(&(bar)[XB_TMO], 1u); break; } } } } while (0)

struct XcdBarrier {
    unsigned* bar; unsigned x;
    volatile LAS unsigned* st;
};

__device__ __forceinline__ XcdBarrier xcd_barrier_post(unsigned* bar, volatile LAS unsigned* st) {
    XcdBarrier b; b.bar = bar; b.x = xb_xcc_id(); b.st = st;
    if (threadIdx.x == 0) (void)xb_add(&bar[XB_XCNT(b.x)], 1u);
    return b;
}
__device__ __forceinline__ void xcd_barrier_complete(unsigned* bar, unsigned x, unsigned& nloc, unsigned& nx) {
    const unsigned G = gridDim.x * gridDim.y * gridDim.z;
    unsigned sum, cnt, mine, sp = 0u;
    for (;;) {
        sum = 0u; cnt = 0u; mine = 0u;
#pragma unroll
        for (unsigned j = 0; j < 16; ++j) { const unsigned c = xb_ld(&bar[XB_XCNT(j)]); sum += c; cnt += (c > 0u) ? 1u : 0u; mine = (j == x) ? c : mine; }
        if (sum == G) break;
        __builtin_amdgcn_s_sleep(1);
        if ((++sp & 255u) == 0u) { if (xb_ld(&bar[XB_TMO])) break; if (sp > XB_SPIN_CAP) { atomicAdd(&bar[XB_TMO], 1u); break; } }
    }
    nloc = mine > 0u ? mine : 1u; nx = cnt > 0u ? cnt : 1u;
}

__device__ __forceinline__ void xcd_barrier(const XcdBarrier& b) {
    asm volatile("s_waitcnt vmcnt(0)" ::: "memory");
    __syncthreads();
    if (threadIdx.x == 0) {
        unsigned* bar = b.bar;
        __builtin_amdgcn_s_waitcnt(0);
        unsigned nloc = b.st[0], nx = b.st[1];
        if (nloc == 0u) { xcd_barrier_complete(bar, b.x, nloc, nx); b.st[0] = nloc; b.st[1] = nx; }
        const unsigned old = xb_add(&bar[XB_XSUB(b.x)], 1u);
        const unsigned gen = old / nloc;
        if (old + 1u == (gen + 1u) * nloc) {
            __builtin_amdgcn_fence(__ATOMIC_RELEASE, "agent");
            asm volatile("s_waitcnt vmcnt(0)" ::: "memory");
            const unsigned og = xb_add(&bar[XB_TOP], 1u);
            const unsigned tg = og / nx;
            if (og + 1u == (tg + 1u) * nx) xb_add(&bar[XB_TOPGEN], 1u);
            else XB_SPIN(xb_ld(&bar[XB_TOPGEN]) == tg, bar);
            __builtin_amdgcn_fence(__ATOMIC_ACQUIRE, "agent");
            xb_add(&bar[XB_XGEN(b.x)], 1u);
            asm volatile("s_waitcnt vmcnt(0)" ::: "memory");
        } else {
            XB_SPIN(xb_ld(&bar[XB_XGEN(b.x)]) == gen, bar);
            __builtin_amdgcn_fence(__ATOMIC_ACQUIRE, "agent");
            asm volatile("s_waitcnt vmcnt(0)" ::: "memory");
        }
    }
    __syncthreads();
}

typedef float f32x16 __attribute__((ext_vector_type(16)));
typedef unsigned u32x4 __attribute__((ext_vector_type(4)));
typedef short s16x4 __attribute__((ext_vector_type(4)));
typedef unsigned u32x2 __attribute__((ext_vector_type(2)));
typedef const float* const __attribute__((address_space(4)))* KARGP;
struct Frame {
    LAS unsigned char* lds;
    volatile LAS unsigned* MISC;
    gu32* ctl;
    int tid, lane, wave;
    int vcu, G;
    KARGP in; float* out; unsigned char* ws;
};
#define IN_X 0
#define IN_C 1
#define IN_POS 2
#define IN_WADA 3
#define IN_BADA 4
#define IN_GPREMIX 5
#define IN_GPOSTMIX 6
#define IN_WIN 7
#define IN_ARE 8
#define IN_AIM 9
#define IN_LOGDT 10
#define IN_BRE 11
#define IN_BIM 12
#define IN_CRE 13
#define IN_CIM 14
#define IN_SSMD 15
#define IN_WGLU 16
#define IN_BGLU 17
#define IN_GATT 18
#define IN_GSSM 19
#define IN_WOUT 20
#define IN_GPREMLP 21
#define IN_GPOSTMLP 22
#define IN_W1 23
#define IN_W2 24

__device__ __forceinline__ float wave_sum(float v) {
#pragma unroll
    for (int o = 1; o < 64; o <<= 1) v += __shfl_xor(v, o);
    return v;
}
__device__ __forceinline__ int crow(int r, int hi) { return (r & 3) + 8 * (r >> 2) + 4 * hi; }


__device__ __forceinline__ void sincos_red(double x, double& s, double& c) {
    double rev = x * 0.15915494309189535; rev -= rint(rev);
    sincospi(2.0 * rev, &s, &c);
}

__device__ __forceinline__ void p0_transpose_item(const float* W, int N, bf16* WT, int ldk, LAS float* scr, int k0, int n0, int kdst, const float* gain, int lane) {
    const int cq = lane & 15, rs = lane >> 4;
    f32x4 v[16];
#pragma unroll
    for (int i = 0; i < 16; ++i) v[i] = MK_NTLD ? __builtin_nontemporal_load((const GAS f32x4*)(W + (size_t)(k0 + 4 * i + rs) * N + n0 + 4 * cq)) : *(const GAS f32x4*)(W + (size_t)(k0 + 4 * i + rs) * N + n0 + 4 * cq);
    if (gain) {
#pragma unroll
        for (int i = 0; i < 16; ++i) v[i] = v[i] * gain[4 * i + rs]; }
#pragma unroll
    for (int i = 0; i < 16; ++i) { LAS float* d = scr + (4 * i + rs) * 65 + 4 * cq; d[0] = v[i].x; d[1] = v[i].y; d[2] = v[i].z; d[3] = v[i].w; }
    LDS_WAIT(); asm volatile("" ::: "memory");
    const int c = lane & 7;
#pragma unroll
    for (int j = 0; j < 8; ++j) { const int n = (lane >> 3) + 8 * j; const LAS float* s = scr + (8 * c) * 65 + n;
        v4u o; o.x = pk2(s[0 * 65], s[1 * 65]); o.y = pk2(s[2 * 65], s[3 * 65]); o.z = pk2(s[4 * 65], s[5 * 65]); o.w = pk2(s[6 * 65], s[7 * 65]);
        *(GAS v4u*)(WT + (size_t)(n0 + n) * ldk + kdst + 8 * c) = o; }
    LDS_WAIT(); asm volatile("" ::: "memory");
}

template <int MODE  > __device__ __forceinline__ void p0_ssm_item(Frame& F, int g, int k, LAS float* scr) {
    const int n = F.lane;
    const double dt = exp((double)F.in[IN_LOGDT][g]);
    const double lr = (double)F.in[IN_ARE][g * 64 + n], li = (double)F.in[IN_AIM][g * 64 + n];
    const double zr = lr * dt, zi = li * dt;
    double s1, c1; sincos_red(zi, s1, c1);
    const double er = exp(zr), ar = er * c1, ai = er * s1;
    const double den = lr * lr + li * li;
    const double cfr = ((ar - 1.0) * lr + ai * li) / den, cfi = (ai * lr - (ar - 1.0) * li) / den;
    double sk, ck; sincos_red(zi * (double)k, sk, ck);
    const double ek = exp(zr * (double)k), pr_d = ek * ck, pi_d = ek * sk;
    const float pr = (float)pr_d, pi = (float)pi_d;
    bf16* KT = (bf16*)(F.ws + WS_KT); bf16* WET = (bf16*)(F.ws + WS_WET); bf16* GT = (bf16*)(F.ws + WS_G);
    const float vr = (float)(pr_d * cfr - pi_d * cfi), vi = (float)(pr_d * cfi + pi_d * cfr);
    const float* bre = F.in[IN_BRE] + (size_t)(g * 64 + n) * 16; const float* bim = F.in[IN_BIM] + (size_t)(g * 64 + n) * 16;
    float br[16], bi[16];
#pragma unroll
    for (int q = 0; q < 4; ++q) { const f32x4 a = ((const f32x4*)bre)[q], b = ((const f32x4*)bim)[q];
#pragma unroll
        for (int e = 0; e < 4; ++e) { br[4 * q + e] = a[e]; bi[4 * q + e] = b[e]; } }
    float crv[16], civ[16];
    { const float* cre = F.in[IN_CRE] + (size_t)g * 1024 + n; const float* cim = F.in[IN_CIM] + (size_t)g * 1024 + n;
#pragma unroll
      for (int p = 0; p < 16; ++p) { crv[p] = cre[p * 64]; civ[p] = cim[p * 64]; } }
    if (k == 32) {
        float* AL = (float*)(F.ws + WS_AL); AL[(g * 64 + n) * 2] = pr; AL[(g * 64 + n) * 2 + 1] = pi;
        unsigned* z = (unsigned*)(KT + (size_t)(g * 33) * 256); z[n] = 0u; z[n + 64] = 0u;
    }
    if ((MODE & 1) && k <= 31) {
        const int sg = 31 - k;
        unsigned wre[8], wim[8];
#pragma unroll
        for (int q = 0; q < 8; ++q) { const float r0 = vr * br[2 * q] - vi * bi[2 * q], r1 = vr * br[2 * q + 1] - vi * bi[2 * q + 1];
            const float i0 = vr * bi[2 * q] + vi * br[2 * q], i1 = vr * bi[2 * q + 1] + vi * br[2 * q + 1]; wre[q] = pk2(r0, r1); wim[q] = pk2(i0, i1); }
        v4u* wb = (v4u*)WET + (size_t)g * 4 * 32 * 64 + (size_t)sg * 64 + (n & 31);
        v4u* dre = wb + (size_t)(n >> 5) * 32 * 64; v4u* dim = wb + (size_t)(2 + (n >> 5)) * 32 * 64;
        dre[0] = (v4u){wre[0], wre[1], wre[2], wre[3]}; dre[32] = (v4u){wre[4], wre[5], wre[6], wre[7]};
        dim[0] = (v4u){wim[0], wim[1], wim[2], wim[3]}; dim[32] = (v4u){wim[4], wim[5], wim[6], wim[7]};
    }
    if ((MODE & 2) && k >= 1) {
#pragma unroll
        for (int p = 0; p < 16; ++p) { const float gr = crv[p] * pr - civ[p] * pi, gi = -(crv[p] * pi + civ[p] * pr);
            bf16* gb = GT + ((size_t)(g * 16 + ((k - 1) >> 1)) * 8 * 64 + (((k - 1) & 1) * 16 + p)) * 8;
            gb[((size_t)(n >> 4) * 64 + ((n >> 3) & 1) * 32) * 8 + (n & 7)] = (bf16)f2bf(gr); gb[((size_t)(4 + (n >> 4)) * 64 + ((n >> 3) & 1) * 32) * 8 + (n & 7)] = (bf16)f2bf(gi); }
    }
    if ((MODE & 4) && k <= 31) {
#pragma unroll
        for (int q = 0; q < 4; ++q) { f32x4 a, b;
#pragma unroll
            for (int e = 0; e < 4; ++e) { a[e] = crv[4 * q + e] * vr - civ[4 * q + e] * vi; b[e] = -(crv[4 * q + e] * vi + civ[4 * q + e] * vr); }
            *(LAS f32x4*)(scr + n * 16 + 4 * q) = a; *(LAS f32x4*)(scr + (64 + n) * 16 + 4 * q) = b;
            *(LAS f32x4*)(scr + 2048 + n * 16 + 4 * q) = (f32x4){br[4 * q], br[4 * q + 1], br[4 * q + 2], br[4 * q + 3]};
            *(LAS f32x4*)(scr + 2048 + (64 + n) * 16 + 4 * q) = (f32x4){bi[4 * q], bi[4 * q + 1], bi[4 * q + 2], bi[4 * q + 3]}; }
        LDS_WAIT(); asm volatile("" ::: "memory");
        f32x4 acc = {0.f, 0.f, 0.f, 0.f};
#pragma unroll 8
        for (int t = 0; t < 32; ++t) acc = __builtin_amdgcn_mfma_f32_16x16x4f32(scr[t * 64 + n], scr[2048 + t * 64 + n], acc, 0, 0, 0);
        const int pp = n & 15, p0 = 4 * (n >> 4);
#pragma unroll
        for (int r = 0; r < 4; ++r) { float mine = acc[r]; if (k == 0 && pp == p0 + r) mine += F.in[IN_SSMD][g * 16 + pp];
            KT[((size_t)(g * 33 + k + 1) * 16 + p0 + r) * 16 + pp] = (bf16)f2bf(mine); }
        LDS_WAIT(); asm volatile("" ::: "memory");
    }
}

__device__ __forceinline__ void p1_row(Frame& F, int m) {
    const int b = m >> 12; const float* mod = (const float*)(F.ws + WS_MOD) + (size_t)b * NMOD;
    const GAS f32x4* xr = (const GAS f32x4*)(F.in[IN_X] + (size_t)m * D) + F.lane;
    f32x4 v[8]; float s = 0.f;
#pragma unroll
    for (int j = 0; j < 8; ++j) { v[j] = (MK_NTLD & 2) ? __builtin_nontemporal_load(xr + 64 * j) : xr[64 * j]; s += (v[j].x * v[j].x + v[j].y * v[j].y) + (v[j].z * v[j].z + v[j].w * v[j].w); }
    const float rstd = 1.0f / sqrtf(wave_sum(s) * (1.f / D) + EPS);
    GAS unsigned long long* o8 = (GAS unsigned long long*)((bf16*)(F.ws + WS_H) + (size_t)m * D) + F.lane;
#pragma unroll
    for (int j = 0; j < 8; ++j) { const int c = 4 * F.lane + 256 * j;
        const f32x4 g = *(const f32x4*)(F.in[IN_GPREMIX] + c), sh = *(const f32x4*)(mod + c), sc = *(const f32x4*)(mod + D + c);
        const f32x4 h = v[j] * rstd * g * (sc + 1.0f) + sh;
        const unsigned long long hv = (unsigned long long)pk2(h.x, h.y) | ((unsigned long long)pk2(h.z, h.w) << 32); if (MK_NTLD & 16) __builtin_nontemporal_store(hv, o8 + 64 * j); else o8[64 * j] = hv; }
}

struct RowX { f32x4 x[8]; u32x2 a[8]; float part; };
__device__ __forceinline__ void row_load(Frame& F, RowX& R, int m, const bf16* abuf, const float* parts) {
    const GAS f32x4* xr = (const GAS f32x4*)(F.in[IN_X] + (size_t)m * D) + F.lane; const GAS u32x2* ar = (const GAS u32x2*)(abuf + (size_t)m * D) + F.lane;
#pragma unroll
    for (int j = 0; j < 8; ++j) { R.x[j] = (MK_NTLD & 2) ? __builtin_nontemporal_load(xr + 64 * j) : xr[64 * j]; R.a[j] = (MK_NTLD & 8) ? __builtin_nontemporal_load(ar + 64 * j) : ar[64 * j]; }
    R.part = F.lane < 32 ? parts[(size_t)m * 32 + F.lane] : 0.f;
}
__device__ __forceinline__ f32x4 bf4(u32x2 w) { return (f32x4){pg8::bf_lo(w.x), pg8::bf_hi(w.x), pg8::bf_lo(w.y), pg8::bf_hi(w.y)}; }
__device__ __forceinline__ void p8_block(Frame& F, int bc) {
    const int b = (bc * 64) >> 12; const float* mod = (const float*)(F.ws + WS_MOD) + (size_t)b * NMOD;
    LAS f32x4* C = (LAS f32x4*)(F.lds + RING_OFF);
    __syncthreads();
    { const int c = 4 * F.tid; C[F.tid] = *(const f32x4*)(mod + 2 * D + c) * *(const f32x4*)(F.in[IN_GPOSTMIX] + c);
      C[512 + F.tid] = *(const f32x4*)(F.in[IN_GPREMLP] + c) * (*(const f32x4*)(mod + 4 * D + c) + 1.0f); C[1024 + F.tid] = *(const f32x4*)(mod + 3 * D + c); }
    LDS_WAIT(); __syncthreads();
    const int m0 = bc * 64 + F.wave * 8;
    const bf16* mix = (const bf16*)(F.ws + WS_MIX); const float* parts = (const float*)(F.ws + WS_POUT);
    RowX cur, nxt; row_load(F, cur, m0, mix, parts);
#pragma unroll 1
    for (int r = 0; r < 8; ++r) {
        row_load(F, nxt, m0 + (r < 7 ? r + 1 : 7), mix, parts);
        const float rs_mix = 1.0f / sqrtf(wave_sum(cur.part) * (1.f / D) + EPS);
        float s = 0.f;
#pragma unroll
        for (int j = 0; j < 8; ++j) { const f32x4 v = cur.x[j] + C[F.lane + 64 * j] * (bf4(cur.a[j]) * rs_mix); cur.x[j] = v; s += (v.x * v.x + v.y * v.y) + (v.z * v.z + v.w * v.w); }
        const float rstd = 1.0f / sqrtf(wave_sum(s) * (1.f / D) + EPS);
        GAS unsigned long long* o8 = (GAS unsigned long long*)((bf16*)(F.ws + WS_H) + (size_t)(m0 + r) * D) + F.lane;
#pragma unroll
        for (int j = 0; j < 8; ++j) { const f32x4 h = cur.x[j] * rstd * C[512 + F.lane + 64 * j] + C[1024 + F.lane + 64 * j]; o8[64 * j] = (unsigned long long)pk2(h.x, h.y) | ((unsigned long long)pk2(h.z, h.w) << 32); }
        cur = nxt;
    }
}
__device__ __forceinline__ void p11_block(Frame& F, int bc) {
    const int b = (bc * 64) >> 12; const float* mod = (const float*)(F.ws + WS_MOD) + (size_t)b * NMOD;
    LAS f32x4* C = (LAS f32x4*)(F.lds + RING_OFF);
    __syncthreads();
    { const int c = 4 * F.tid; C[F.tid] = *(const f32x4*)(mod + 2 * D + c) * *(const f32x4*)(F.in[IN_GPOSTMIX] + c); C[512 + F.tid] = *(const f32x4*)(mod + 5 * D + c) * *(const f32x4*)(F.in[IN_GPOSTMLP] + c); }
    LDS_WAIT(); __syncthreads();
    const int m0 = bc * 64 + F.wave * 8;
    const bf16* mix = (const bf16*)(F.ws + WS_MIX); const float* parts = (const float*)(F.ws + WS_POUT);
    const bf16* y2 = (const bf16*)(F.ws + WS_H); const float* parts2 = (const float*)(F.ws + WS_PY2);
    RowX cur, nxt; u32x2 ycur[8], ynxt[8]; float pcur, pnxt = 0.f;
    row_load(F, cur, m0, mix, parts);
    { const GAS u32x2* yr = (const GAS u32x2*)(y2 + (size_t)m0 * D) + F.lane;
#pragma unroll
      for (int j = 0; j < 8; ++j) ycur[j] = (MK_NTLD & 8) ? __builtin_nontemporal_load(yr + 64 * j) : yr[64 * j];
      pcur = F.lane < 32 ? parts2[(size_t)m0 * 32 + F.lane] : 0.f; }
#pragma unroll 1
    for (int r = 0; r < 8; ++r) {
        { const int mn = m0 + (r < 7 ? r + 1 : 7); row_load(F, nxt, mn, mix, parts); const GAS u32x2* yr = (const GAS u32x2*)(y2 + (size_t)mn * D) + F.lane;
#pragma unroll
            for (int j = 0; j < 8; ++j) ynxt[j] = (MK_NTLD & 8) ? __builtin_nontemporal_load(yr + 64 * j) : yr[64 * j];
            pnxt = F.lane < 32 ? parts2[(size_t)mn * 32 + F.lane] : 0.f; }
        const float rs1 = 1.0f / sqrtf(wave_sum(cur.part) * (1.f / D) + EPS), rs2 = 1.0f / sqrtf(wave_sum(pcur) * (1.f / D) + EPS);
        GAS f32x4* orow = (GAS f32x4*)(F.out + (size_t)(m0 + r) * D) + F.lane;
#pragma unroll
        for (int j = 0; j < 8; ++j) { const f32x4 ov = cur.x[j] + C[F.lane + 64 * j] * (bf4(cur.a[j]) * rs1) + C[512 + F.lane + 64 * j] * (bf4(ycur[j]) * rs2); if (MK_NTLD & 4) __builtin_nontemporal_store(ov, orow + 64 * j); else orow[64 * j] = ov; }
        cur = nxt; pcur = pnxt;
#pragma unroll
        for (int j = 0; j < 8; ++j) ycur[j] = ynxt[j];
    }
}

__device__ __forceinline__ bf16x8 ld8(const bf16* p) { return *(const bf16x8*)p; }
__device__ __forceinline__ s16x4 vtr(LAS const unsigned char* p) { typedef short v4i16_t __attribute__((ext_vector_type(4))); return __builtin_bit_cast(s16x4, __builtin_amdgcn_ds_read_tr16_b64_v4i16((LAS v4i16_t*)p)); }
constexpr int ATT_UNITS = BATCH * 6 * 3 * 16, ATT_V = 49152;
struct AttU { int hh, g, dsh, res, i0; size_t rowb; };
__device__ __forceinline__ AttU att_decode(int u) { AttU a; const int b = u / 288; int rem = u - b * 288; a.hh = rem / 48; rem -= a.hh * 48; a.g = rem >> 4; const int blk = rem & 15;
    a.dsh = 2 * a.g; const int nb = 16 >> a.dsh; a.res = blk / nb; a.i0 = (blk - a.res * nb) * 256; a.rowb = (size_t)b * SEQ; return a; }
__device__ __forceinline__ int att_unit_of(Frame& F, int k) {
    if (F.G == 256) { if (k < 4) return F.vcu + 256 * k; if (F.vcu >= NG * BATCH && k < 8) return 1024 + (F.vcu - NG * BATCH) + 32 * (k - 4); return ATT_UNITS; }
    const int u = F.vcu + k * F.G; return u < ATT_UNITS ? u : ATT_UNITS;
}
__device__ __forceinline__ void att_issue(Frame& F, const AttU& a, u32x4 (&kv)[12], bf16x8 (&qn)[4]) {
    const bf16* proj = (const bf16*)(F.ws + WS_PROJ);
#pragma unroll
    for (int i = 0; i < 6; ++i) { const int ck = F.tid + 512 * i, row = ck >> 3, ch = ck & 7; int kidx = a.i0 - 128 + row; kidx = kidx < 0 ? 0 : kidx;
        const bf16* rp = proj + (a.rowb + ((size_t)kidx << a.dsh) + a.res) * NIN + a.hh * 64 + ch * 8;
        kv[i] = *(const u32x4*)(rp + COL_K); kv[6 + i] = *(const u32x4*)(rp + COL_V); }
    const bf16* qp = proj + (a.rowb + ((size_t)(a.i0 + 32 * F.wave + (F.lane & 31)) << a.dsh) + a.res) * NIN + (a.g * 6 + a.hh) * 64 + (F.lane >> 5) * 8;
#pragma unroll
    for (int kk = 0; kk < 4; ++kk) qn[kk] = ld8(qp + 16 * kk);
}
template <int MODE  > __device__ __forceinline__ void attn_phase(Frame& F) {
    const int lane = F.lane, r32 = lane & 31, hi = lane >> 5, w = F.wave;
    LAS unsigned char* L = F.lds + RING_OFF;
    u32x4 kv[12]; bf16x8 qn[4];
    int k_ = 0; int u = att_unit_of(F, 0);
    if (u < ATT_UNITS) { const AttU a = att_decode(u); att_issue(F, a, kv, qn); }
    int kch[4];
#pragma unroll
    for (int kk = 0; kk < 4; ++kk) kch[kk] = (32 * w + r32) * 128 + (((2 * kk + hi) ^ (r32 & 7)) * 16);
    const int grp = lane >> 4, tq = (grp >> 1) * 4 + ((lane & 15) >> 2), tp = lane & 3;
    int vch[2];
#pragma unroll
    for (int dt = 0; dt < 2; ++dt) vch[dt] = ATT_V + (32 * w + tq) * 128 + (((4 * dt + 2 * (grp & 1) + (tp >> 1)) ^ (tq & 7)) * 16) + 8 * (tp & 1);
    while (u < ATT_UNITS) {
        const AttU a = att_decode(u);
        __syncthreads();
#pragma unroll
        for (int i = 0; i < 6; ++i) { const int ck = F.tid + 512 * i, row = ck >> 3, ch = ck & 7; const int off = row * 128 + ((ch ^ (row & 7)) * 16);
            *(LAS u32x4*)(L + off) = kv[i]; *(LAS u32x4*)(L + ATT_V + off) = kv[6 + i]; }
        bf16x8 qf[4];
#pragma unroll
        for (int kk = 0; kk < 4; ++kk) qf[kk] = qn[kk];
        LDS_WAIT(); __syncthreads();
        const int un = att_unit_of(F, ++k_);
        if (un < ATT_UNITS) { const AttU an = att_decode(un); att_issue(F, an, kv, qn); }
        const int iq = a.i0 + 32 * w;
        const int jmin = (iq >= 128) ? 0 : (128 - iq) >> 5;
        f32x16 S[5];
#pragma unroll
        for (int j = 0; j < 5; ++j) S[j] = (f32x16){};
        if (MODE & 1) {
            bf16x8 kf[4][5];
#pragma unroll
            for (int j = 0; j < 5; ++j) kf[0][j] = *(const LAS bf16x8*)(L + kch[0] + j * 4096);
#pragma unroll
            for (int kk = 0; kk < 4; ++kk) {
                if (kk < 3) {
#pragma unroll
                    for (int j = 0; j < 5; ++j) kf[kk + 1][j] = *(const LAS bf16x8*)(L + kch[kk + 1] + j * 4096); }
                __builtin_amdgcn_sched_barrier(0);
#pragma unroll
                for (int j = 0; j < 5; ++j) S[j] = __builtin_amdgcn_mfma_f32_32x32x16_bf16(kf[kk][j], qf[kk], S[j], 0, 0, 0);
                __builtin_amdgcn_sched_barrier(0);
            } }
        const float NEG = -INFINITY; float mx = NEG, l = 1.f;
        if (MODE & 2) {
#pragma unroll
        for (int r = 0; r < 16; ++r) { const int bb = crow(r, hi); if (bb < r32) S[0][r] = NEG; if (bb > r32) S[4][r] = NEG; }
#pragma unroll
        for (int j = 0; j < 4; ++j) if (j < jmin) {
#pragma unroll
            for (int r = 0; r < 16; ++r) S[j][r] = NEG; }
#pragma unroll
        for (int j = 0; j < 5; ++j)
#pragma unroll
            for (int r = 0; r < 16; ++r) mx = fmaxf(mx, S[j][r]);
        mx = fmaxf(mx, __shfl_xor(mx, 32));
        l = 0.f;
#pragma unroll
        for (int j = 0; j < 5; ++j)
#pragma unroll
            for (int r = 0; r < 16; ++r) { const float p = __builtin_amdgcn_exp2f(S[j][r] - mx); S[j][r] = p; l += p; }
        l += __shfl_xor(l, 32);
        } else { _Pragma("unroll") for (int j = 0; j < 5; ++j) asm volatile("" : "+v"(S[j])); }
        f32x16 O0 = (f32x16){}, O1 = (f32x16){}, O2 = (f32x16){}, O3 = (f32x16){};
        if (MODE & 4) {
            s16x4 vq[10][4];
#define ATT_VRD(st) do { _Pragma("unroll") for (int dt = 0; dt < 2; ++dt) { vq[st][2 * dt] = vtr(L + vch[dt] + (16 * (st)) * 128); vq[st][2 * dt + 1] = vtr(L + vch[dt] + (16 * (st) + 8) * 128); } } while (0)
            ATT_VRD(0); ATT_VRD(1);
#pragma unroll
            for (int st = 0; st < 10; ++st) {
                const int j = st >> 1, s = st & 1;
                if (st + 2 < 10) ATT_VRD(st + 2);
                bf16x8 pf;
#pragma unroll
                for (int e = 0; e < 8; e += 2) { const unsigned wd = pg8::cvt_pk_bf16(S[j][8 * s + e], S[j][8 * s + e + 1]); pf[e] = (short)(wd & 0xffffu); pf[e + 1] = (short)(wd >> 16); }
                __builtin_amdgcn_sched_barrier(0);
                const bf16x8 vf0 = {vq[st][0][0], vq[st][0][1], vq[st][0][2], vq[st][0][3], vq[st][1][0], vq[st][1][1], vq[st][1][2], vq[st][1][3]};
                const bf16x8 vf1 = {vq[st][2][0], vq[st][2][1], vq[st][2][2], vq[st][2][3], vq[st][3][0], vq[st][3][1], vq[st][3][2], vq[st][3][3]};
                if (s == 0) { O0 = __builtin_amdgcn_mfma_f32_32x32x16_bf16(vf0, pf, O0, 0, 0, 0); O1 = __builtin_amdgcn_mfma_f32_32x32x16_bf16(vf1, pf, O1, 0, 0, 0); }
                else { O2 = __builtin_amdgcn_mfma_f32_32x32x16_bf16(vf0, pf, O2, 0, 0, 0); O3 = __builtin_amdgcn_mfma_f32_32x32x16_bf16(vf1, pf, O3, 0, 0, 0); }
                __builtin_amdgcn_sched_barrier(0);
            }
#undef ATT_VRD
        }
        O0 = O0 + O2; O1 = O1 + O3;
        if (!(MODE & 8)) { asm volatile("" :: "v"(O0), "v"(O1), "v"(mx), "v"(l)); if (!(MODE & 4)) { _Pragma("unroll") for (int j = 0; j < 5; ++j) asm volatile("" :: "v"(S[j])); } u = un; continue; }
        const float il = 1.0f / l;
        const size_t qrow = a.rowb + ((size_t)(iq + r32) << a.dsh) + a.res;
        bf16* ob = (bf16*)(F.ws + WS_OBUF) + ((size_t)a.g * M + qrow) * NKV + a.hh * 64;
#pragma unroll
        for (int t = 0; t < 2; ++t) {
#pragma unroll
            for (int ip = 0; ip < 2; ++ip) {
                const f32x16& O = t == 0 ? O0 : O1;
                const unsigned a0 = pg8::cvt_pk_bf16(O[8 * ip] * il, O[8 * ip + 1] * il), a1 = pg8::cvt_pk_bf16(O[8 * ip + 2] * il, O[8 * ip + 3] * il);
                const unsigned b0 = pg8::cvt_pk_bf16(O[8 * ip + 4] * il, O[8 * ip + 5] * il), b1 = pg8::cvt_pk_bf16(O[8 * ip + 6] * il, O[8 * ip + 7] * il);
                const auto r0 = __builtin_amdgcn_permlane32_swap(a0, b0, false, false), r1 = __builtin_amdgcn_permlane32_swap(a1, b1, false, false);
                u32x4 wv;
                if (hi == 0) { wv.x = a0; wv.y = a1; wv.z = r0[1]; wv.w = r1[1]; } else { wv.x = r0[0]; wv.y = r1[0]; wv.z = b0; wv.w = b1; }
                *(u32x4*)(ob + 32 * t + 16 * ip + 8 * hi) = wv; } }
        if (hi == 0) ((float*)(F.ws + WS_LSE))[((size_t)a.g * M + qrow) * 8 + a.hh] = mx + __builtin_amdgcn_logf(l);
        u = un;
    }
    __syncthreads();
}

__device__ __forceinline__ void att_combine_rows(Frame& F, int m0) {
    const float* lse = (const float*)(F.ws + WS_LSE); const bf16* ob = (const bf16*)(F.ws + WS_OBUF);
    const int l = F.lane < 48 ? F.lane : 47, hd = l >> 3;
    u32x4 o[2][3]; float ls[2][3];
#pragma unroll
    for (int r = 0; r < 2; ++r)
#pragma unroll
        for (int g = 0; g < 3; ++g) { o[r][g] = *(const u32x4*)(ob + ((size_t)g * M + m0 + r) * NKV + 8 * l); ls[r][g] = lse[((size_t)g * M + m0 + r) * 8 + hd]; }
    const f32x4 g0 = *(const f32x4*)(F.in[IN_GATT] + 8 * l), g1 = *(const f32x4*)(F.in[IN_GATT] + 8 * l + 4);
#pragma unroll
    for (int r = 0; r < 2; ++r) {
        const float mx = fmaxf(ls[r][0], fmaxf(ls[r][1], ls[r][2])); const float w0 = __builtin_amdgcn_exp2f(ls[r][0] - mx), w1 = __builtin_amdgcn_exp2f(ls[r][1] - mx), w2 = __builtin_amdgcn_exp2f(ls[r][2] - mx);
        const float inv = 1.0f / (w0 + w1 + w2); const float a0 = w0 * inv, a1 = w1 * inv, a2 = w2 * inv;
        float v[8]; float ss = 0.f;
#pragma unroll
        for (int e = 0; e < 4; ++e) { const unsigned x0 = o[r][0][e], x1 = o[r][1][e], x2 = o[r][2][e];
            v[2 * e] = a0 * pg8::bf_lo(x0) + a1 * pg8::bf_lo(x1) + a2 * pg8::bf_lo(x2); v[2 * e + 1] = a0 * pg8::bf_hi(x0) + a1 * pg8::bf_hi(x1) + a2 * pg8::bf_hi(x2);
            ss += v[2 * e] * v[2 * e] + v[2 * e + 1] * v[2 * e + 1]; }
        if (F.lane >= 48) ss = 0.f;
        const float rstd = 1.0f / sqrtf(wave_sum(ss) * (1.f / NKV) + EPS);
        u32x4 wv; wv.x = pg8::cvt_pk_bf16(v[0] * rstd * g0.x, v[1] * rstd * g0.y); wv.y = pg8::cvt_pk_bf16(v[2] * rstd * g0.z, v[3] * rstd * g0.w);
        wv.z = pg8::cvt_pk_bf16(v[4] * rstd * g1.x, v[5] * rstd * g1.y); wv.w = pg8::cvt_pk_bf16(v[6] * rstd * g1.z, v[7] * rstd * g1.w);
        if (F.lane < 48) *(u32x4*)((bf16*)(F.ws + WS_AOUT) + (size_t)(m0 + r) * KOUT + 896 + 8 * l) = wv;
    }
}

constexpr int SA_E = 66560;
__device__ __forceinline__ float gelu_tanh(float x) { const float u = x * (2.3022082f + 0.1029432f * x * x); return x * __builtin_amdgcn_rcpf(1.0f + __builtin_amdgcn_exp2f(-u)); }
constexpr int SF_CY = 0, SF_U = 34816, SF_KT = 68096, SF_Y = 84992;
__device__ __forceinline__ void ssm_fused_block(Frame& F, int unit) {
    const int tid = F.tid, lane = F.lane, r32 = lane & 31, hi = lane >> 5, w = F.wave;
    const int g = unit >> 2, b = unit & 3;
    LAS unsigned char* L = F.lds + RING_OFF;
    {
        const int rt = w & 3, chf = w >> 2;
        const v4u* ap = (const v4u*)(F.ws + WS_WET) + (size_t)(g * 4 + rt) * 32 * 64 + lane;
        bf16x8 af[32];
#pragma unroll
        for (int sg = 0; sg < 32; ++sg) af[sg] = __builtin_bit_cast(bf16x8, ap[sg * 64]);
#pragma unroll 1
        for (int half = 0; half < 2; ++half) {
            const bf16* ut = (const bf16*)(F.ws + WS_UT) + ((size_t)g * M + b * SEQ + half * 2048) * 16;
            u32x4 su[8];
#pragma unroll
            for (int i = 0; i < 8; ++i) su[i] = *(const u32x4*)(ut + (size_t)(tid + 512 * i) * 8);
#pragma unroll
            for (int i = 0; i < 8; ++i) { const int ch = tid + 512 * i, tok = ch >> 1; *(LAS u32x4*)(L + (tok >> 5) * 1040 + (tok & 31) * 32 + (ch & 1) * 16) = su[i]; }
            LDS_WAIT(); __syncthreads();
            f32x16 acc = (f32x16){}, acc2 = (f32x16){};
            const LAS unsigned char* ub = L + (chf * 32 + r32) * 1040 + hi * 16;
#pragma unroll
            for (int sg = 0; sg < 32; sg += 2) { acc = __builtin_amdgcn_mfma_f32_32x32x16_bf16(af[sg], *(const LAS bf16x8*)(ub + sg * 32), acc, 0, 0, 0);
                                                 acc2 = __builtin_amdgcn_mfma_f32_32x32x16_bf16(af[sg + 1], *(const LAS bf16x8*)(ub + sg * 32 + 32), acc2, 0, 0, 0); }
            acc = acc + acc2;
            LAS float* El = (LAS float*)(L + SA_E) + (half * 64 + chf * 32 + r32) * 128 + rt * 32;
#pragma unroll
            for (int i = 0; i < 4; ++i) *(LAS f32x4*)(El + 8 * i + 4 * hi) = (f32x4){acc[4 * i], acc[4 * i + 1], acc[4 * i + 2], acc[4 * i + 3]};
            LDS_WAIT(); __syncthreads();
        }
    }
    const bf16* utb = (const bf16*)(F.ws + WS_UT) + ((size_t)g * M + b * SEQ) * 16;
    const bf16* KT = (const bf16*)(F.ws + WS_KT) + (size_t)g * 33 * 256;
    u32x4 su[4], sk[3];
#pragma unroll
    for (int i = 0; i < 3; ++i) { const int ch = tid + 512 * i; sk[i] = *(const u32x4*)(KT + (size_t)(ch < 1056 ? ch : 0) * 8); }
#pragma unroll
    for (int i = 0; i < 4; ++i) su[i] = *(const u32x4*)(utb + (size_t)(tid + 512 * i) * 8);
    bf16x8 gf[2][8];
#pragma unroll
    for (int h = 0; h < 2; ++h) { const int tp = h == 0 ? w : 15 - w; const v4u* gp = (const v4u*)(F.ws + WS_G) + (size_t)(g * 16 + tp) * 8 * 64 + lane;
#pragma unroll
        for (int kk = 0; kk < 8; ++kk) gf[h][kk] = __builtin_bit_cast(bf16x8, gp[kk * 64]); }
    if (w == 0) {
        const float* AL = (const float*)(F.ws + WS_AL); const float alr = AL[(g * 64 + lane) * 2], ali = AL[(g * 64 + lane) * 2 + 1];
        const LAS float* El = (const LAS float*)(L + SA_E); LAS bf16* CY = (LAS bf16*)(L + SF_CY);
        float cr = 0.f, ci = 0.f;
#pragma unroll 8
        for (int c = 0; c < 128; ++c) { CY[c * 136 + lane] = (bf16)f2bf(cr); CY[c * 136 + 64 + lane] = (bf16)f2bf(ci);
            const float er = El[c * 128 + lane], ei = El[c * 128 + 64 + lane]; const float nr = alr * cr - ali * ci + er, ni = alr * ci + ali * cr + ei; cr = nr; ci = ni; }
    }
    LDS_WAIT(); __syncthreads();
#pragma unroll
    for (int i = 0; i < 3; ++i) { const int ch = tid + 512 * i; if (ch < 1056) *(LAS u32x4*)(L + SF_KT + ch * 16) = sk[i]; }
    const LAS unsigned char* ub = L + SF_U + r32 * 1040 + hi * 16;
#pragma unroll 1
    for (int cbl = 0; cbl < 4; ++cbl) {
#pragma unroll
        for (int i = 0; i < 4; ++i) { const int ch = tid + 512 * i, tok = ch >> 1; *(LAS u32x4*)(L + SF_U + (tok >> 5) * 1040 + (tok & 31) * 32 + (ch & 1) * 16) = su[i]; }
        LDS_WAIT(); __syncthreads();
        if (cbl < 3) {
#pragma unroll
            for (int i = 0; i < 4; ++i) su[i] = *(const u32x4*)(utb + (size_t)(cbl + 1) * 1024 * 16 + (size_t)(tid + 512 * i) * 8); }
        const LAS unsigned char* cyb = L + SF_CY + (32 * cbl + r32) * 272 + hi * 16;
#pragma unroll
        for (int h = 0; h < 2; ++h) {
            const int tau0 = 2 * (h == 0 ? w : 15 - w);
            f32x16 acc = (f32x16){}, acc2 = (f32x16){};
#pragma unroll
            for (int kk = 0; kk < 8; kk += 2) { acc = __builtin_amdgcn_mfma_f32_32x32x16_bf16(gf[h][kk], *(const LAS bf16x8*)(cyb + 32 * kk), acc, 0, 0, 0);
                                                acc2 = __builtin_amdgcn_mfma_f32_32x32x16_bf16(gf[h][kk + 1], *(const LAS bf16x8*)(cyb + 32 * kk + 32), acc2, 0, 0, 0); }
            const LAS unsigned char* kb = L + SF_KT + (tau0 + 1) * 512 + r32 * 32 + hi * 16;
#pragma unroll 2
            for (int sg = 0; sg < tau0 + 2; sg += 2) {
                acc = __builtin_amdgcn_mfma_f32_32x32x16_bf16(*(const LAS bf16x8*)(kb - sg * 512), *(const LAS bf16x8*)(ub + sg * 32), acc, 0, 0, 0);
                acc2 = __builtin_amdgcn_mfma_f32_32x32x16_bf16(*(const LAS bf16x8*)(kb - (sg + 1) * 512), *(const LAS bf16x8*)(ub + (sg + 1) * 32), acc2, 0, 0, 0); }
            acc = acc + acc2;
#pragma unroll
            for (int i = 0; i < 4; ++i) {
                u32x2 o; o.x = pg8::cvt_pk_bf16(gelu_tanh(acc[4 * i]), gelu_tanh(acc[4 * i + 1])); o.y = pg8::cvt_pk_bf16(gelu_tanh(acc[4 * i + 2]), gelu_tanh(acc[4 * i + 3]));
                *(LAS u32x2*)(L + SF_Y + r32 * 1040 + (tau0 + (i >> 1)) * 32 + (8 * (i & 1) + 4 * hi) * 2) = o; }
        }
        LDS_WAIT(); __syncthreads();
        bf16* yb = (bf16*)(F.ws + WS_YBUF) + ((size_t)b * SEQ + cbl * 1024) * NU + g * 16;
#pragma unroll
        for (int i = 0; i < 4; ++i) { const int ch = tid + 512 * i, tok = ch >> 1;
            *(u32x4*)(yb + (size_t)tok * NU + 8 * (ch & 1)) = *(const LAS u32x4*)(L + SF_Y + (tok >> 5) * 1040 + (tok & 31) * 32 + (ch & 1) * 16); }
    }
    __syncthreads();
}

__device__ __forceinline__ void p0_gemv_item(Frame& F, int item) {
    LAS float* sc = (LAS float*)(F.lds + RING_OFF); LAS float* red = (LAS float*)(F.lds + RING_OFF + 32768);
    const float* W = F.in[IN_WADA]; const int n0 = item * 64;
    const int cg = F.lane & 15, rsub = F.lane >> 4;
    f32x4 acc[4] = {{0.f, 0.f, 0.f, 0.f}, {0.f, 0.f, 0.f, 0.f}, {0.f, 0.f, 0.f, 0.f}, {0.f, 0.f, 0.f, 0.f}};
#pragma unroll 8
    for (int it = 0; it < 64; ++it) { const int k = it * 32 + F.wave * 4 + rsub;
        const f32x4 wv = MK_NTLD ? __builtin_nontemporal_load((const f32x4*)(W + (size_t)k * NMOD + n0 + 4 * cg)) : *(const f32x4*)(W + (size_t)k * NMOD + n0 + 4 * cg);
#pragma unroll
        for (int b = 0; b < 4; ++b) acc[b] = acc[b] + wv * sc[b * D + k]; }
#pragma unroll
    for (int b = 0; b < 4; ++b)
#pragma unroll
        for (int e = 0; e < 4; ++e) { float v = acc[b][e]; v += __shfl_xor(v, 16); v += __shfl_xor(v, 32); acc[b][e] = v; }
    if (rsub == 0) {
#pragma unroll
        for (int b = 0; b < 4; ++b) *(LAS f32x4*)(red + (F.wave * 4 + b) * 64 + 4 * cg) = acc[b]; }
    __syncthreads();
    if (F.tid < 256) { const int b = F.tid >> 6, c = F.tid & 63; float s = F.in[IN_BADA][n0 + c];
#pragma unroll
        for (int w = 0; w < 8; ++w) s += red[(w * 4 + b) * 64 + c];
        ((float*)(F.ws + WS_MOD))[(size_t)b * NMOD + n0 + c] = s; }
    asm volatile("s_waitcnt vmcnt(0)" ::: "memory");
    __syncthreads();
    if (F.tid == 0) {
        __builtin_amdgcn_fence(__ATOMIC_RELEASE, "agent"); asm volatile("s_waitcnt vmcnt(0)" ::: "memory");
        __hip_atomic_fetch_add(F.ctl + CW_GEMV, 1u, RLX_AGENT); }
}
__device__ __forceinline__ void gemv_wait(Frame& F) {
    if (F.tid == 0) { unsigned sp = 0;
        while (__hip_atomic_load(F.ctl + CW_GEMV, RLX_AGENT) < (unsigned)(NMOD / 64)) { __builtin_amdgcn_s_sleep(2); if (++sp > (1u << 22)) { __hip_atomic_store(F.ctl + CW_TMO, 0x6E3Fu, RLX_AGENT); break; } }
        __builtin_amdgcn_fence(__ATOMIC_ACQUIRE, "agent"); asm volatile("s_waitcnt vmcnt(0)" ::: "memory"); }
    __syncthreads();
}

__device__ __forceinline__ void p0_prologue(Frame& F) {
    constexpr int NGEMV = NMOD / 64;
    __syncthreads();
    if ((int)blockIdx.x < NGEMV) {
        LAS float* sc = (LAS float*)(F.lds + RING_OFF);
        for (int i = F.tid; i < BATCH * D; i += NWAVES * 64) { const float c = F.in[IN_C][i]; sc[i] = c / (1.0f + __expf(-c)); }
        __syncthreads();
        for (int r_ = 0; r_ < (MK_P0SUB == 1 ? 2 : 1); ++r_) for (int it = blockIdx.x; it < NGEMV; it += F.G) p0_gemv_item(F, it);
    }
    LAS float* scr = (LAS float*)(F.lds + RING_OFF + F.wave * 16640);
    const int gw = F.vcu * NWAVES + F.wave, NGW = F.G * NWAVES;
    if (!MK_SSMTAIL) for (int it = gw; it < NG * 33; it += NGW) p0_ssm_item<7>(F, it / 33, it % 33, scr);
    if (MK_P0SUB == 2) for (int it = gw; it < NG * 33; it += NGW) p0_ssm_item<MK_P0MODE>(F, it / 33, it % 33, scr);
    constexpr int I_IN = (D / 64) * (NIN / 64);
    bf16* WIN = (bf16*)(F.ws + WS_WIN);
    for (int r_ = 0; r_ < (MK_P0SUB == 3 ? 2 : 1); ++r_) for (int r = gw; r < I_IN; r += NGW) { const int nb = NIN / 64; p0_transpose_item(F.in[IN_WIN], NIN, WIN, D, scr, 64 * (r / nb), 64 * (r % nb), 64 * (r / nb), nullptr, F.lane); }
    { const int gt = gw * 64 + F.lane, NT = NGW * 64; float* rope = (float*)(F.ws + WS_ROPE); const int* pos = (const int*)F.in[IN_POS];
      for (int r_ = 0; r_ < (MK_P0SUB == 4 ? 2 : 1); ++r_) for (int it = gt; it < M * 8; it += NT) { const int row = it >> 3, j = it & 7;
          const float f = (float)exp(-(double)j * 0.125 * 13.122363377404328);
          const float ang = (float)pos[row] * f; double s, c; sincos_red((double)ang, s, c);
          rope[row * 16 + j] = (float)c; rope[row * 16 + 8 + j] = (float)s; } }
}

__device__ __forceinline__ void late_weight_items(Frame& F, int wi, int nw) {
    LAS float* scr = (LAS float*)(F.lds + RING_OFF + F.wave * 16640);
    constexpr int I_GLU = (NU / 64) * (NU / 64), I_OUT = (KOUT / 64) * (D / 64), I_ZP = 128;
    bf16* WGLU = (bf16*)(F.ws + WS_WGLU); bf16* WOUT = (bf16*)(F.ws + WS_WOUT);
    for (int it = wi; it < I_GLU + I_OUT + I_ZP; it += nw) {
        int r = it;
        if (r < I_GLU) { const int nb = NU / 64; p0_transpose_item(F.in[IN_WGLU], NU, WGLU, NU, scr, 64 * (r / nb), 64 * (r % nb), 64 * (r / nb), nullptr, F.lane); continue; } r -= I_GLU;
        if (r < I_OUT) { const int nb = D / 64; const int k0 = 64 * (r / nb);
            p0_transpose_item(F.in[IN_WOUT], D, WOUT, KOUT, scr, k0, 64 * (r % nb), k0 < NKV ? k0 + NU : k0 - NKV, k0 < NKV ? nullptr : F.in[IN_GSSM] + (k0 - NKV), F.lane); continue; } r -= I_OUT;
        { v4u* z = (v4u*)(WGLU + (size_t)(NU + r) * NU); for (int i = F.lane; i < NU * 2 / 16; i += 64) z[i] = (v4u){0u, 0u, 0u, 0u}; }
    }
}
__device__ __forceinline__ void mlp_weight_items(Frame& F, int wi, int nw, int lo_, int hi_) {
    LAS float* scr = (LAS float*)(F.lds + RING_OFF + F.wave * 16640);
    constexpr int I_1 = (D / 64) * (FF / 64);
    bf16* W1 = (bf16*)(F.ws + WS_W1); bf16* W2 = (bf16*)(F.ws + WS_W2);
    for (int it = lo_ + wi; it < hi_; it += nw) {
        if (it < I_1) { const int nb = FF / 64; p0_transpose_item(F.in[IN_W1], FF, W1, D, scr, 64 * (it / nb), 64 * (it % nb), 64 * (it / nb), nullptr, F.lane); }
        else { const int r = it - I_1, nb = D / 64; p0_transpose_item(F.in[IN_W2], D, W2, FF, scr, 64 * (r / nb), 64 * (r % nb), 64 * (r / nb), nullptr, F.lane); }
    }
}

struct Args { const float* in[25]; float* out; unsigned char* ws; int ph_lo, ph_hi, li, pad; };
__global__ void __launch_bounds__(NWAVES * 64, 2) mk_fwd(Args args) {
    extern __shared__ __attribute__((aligned(16))) unsigned char lds[];
    Frame F;
    F.lds = (LAS unsigned char*)lds;
    F.MISC = (volatile LAS unsigned*)(F.lds + MISC_OFF);
    F.tid = threadIdx.x; F.lane = F.tid & 63; F.wave = __builtin_amdgcn_readfirstlane(F.tid >> 6);
    F.G = gridDim.x; { const int bx = blockIdx.x; F.vcu = (F.G % 8 == 0) ? (bx % 8) * (F.G / 8) + bx / 8 : bx; }
    unsigned char* ws = args.ws; F.ws = ws; F.out = args.out;
    F.in = (KARGP)__builtin_amdgcn_kernarg_segment_ptr();
#define RELOAD_IN() asm volatile("" : "+s"(F.in))
    F.ctl = (gu32*)(ws + WS_CTL);
    for (int u = F.tid; u < (LDS_BYTES - LDSCTL_OFF) / 4; u += NWAVES * 64) ((LAS unsigned*)(F.lds + LDSCTL_OFF))[u] = 0u;
    __syncthreads();
    XcdBarrier bar; bar.bar = (unsigned*)(F.ctl + CW_BAR); bar.x = 0; bar.st = nullptr;
    if (!MK_PER_PHASE) bar = xcd_barrier_post((unsigned*)(F.ctl + CW_BAR), F.MISC + 8);
#define GRID_BAR() do { if (MK_PER_PHASE) { if (F.tid == 0) __hip_atomic_store(F.ctl + CW_TMO, 0xBADBA0u, RLX_AGENT); } else { xcd_barrier(bar); } } while (0)
    const int lo = args.ph_lo, hi = args.ph_hi;
#ifndef MK_PHASE_MASK
#define MK_PHASE_MASK 0xFFF
#endif
#define IN(k) (((MK_PHASE_MASK >> (k)) & 1) && lo <= (k) && (k) < hi)
#define BOTH(k) (IN(k) && IN((k) + 1))
    const int gw = F.vcu * NWAVES + F.wave, NGW = F.G * NWAVES;

    if (IN(0)) { RELOAD_IN(); for (int rep_ = 0; rep_ < ((MK_DUP == 0) ? 2 : 1); ++rep_) { p0_prologue(F); }
        if (!MK_PER_PHASE) { gemv_wait(F);
            if (MK_P1BAL && F.G == 256) {
                for (int m = gw; m < 7 * NGW; m += NGW) p1_row(F, m);
                if ((int)blockIdx.x >= NMOD / 64) { const int fw = ((int)blockIdx.x - NMOD / 64) * NWAVES + F.wave; for (int m = 7 * NGW + fw; m < M; m += (F.G - NMOD / 64) * NWAVES) p1_row(F, m); } }
            else for (int m = gw; m < M; m += NGW) p1_row(F, m); }
        if (BOTH(0)) GRID_BAR(); }
    if (IN(1) && MK_PER_PHASE) { RELOAD_IN(); for (int m = gw; m < M; m += NGW) p1_row(F, m); }
    if (IN(2)) { RELOAD_IN(); for (int rep_ = 0; rep_ < ((MK_DUP == 2) ? 2 : 1); ++rep_) {
        pg8::Gemm g{(const pg8::bf16_t*)(ws + WS_H), (const pg8::bf16_t*)(ws + WS_WIN), M, NIN, D}; pg8::StaticOrder S; S.init(M, NIN, F.G, (int)blockIdx.x); S.wgm = MK_WGM2;
        pg8::EpiProj E{(pg8::bf16_t*)(ws + WS_PROJ), (const float*)(ws + WS_ROPE), QSCALE, (pg8::bf16_t*)(ws + WS_UT)};
        pg8::gemm_phase<pg8::EpiProj, pg8::StaticOrder, PG8_ALIGN, PG8_SP2>(F.lds + RING_OFF, g, S, E);
        { constexpr int NWG = (M / 256) * (NIN / 256); const int nidle = F.G - NWG % F.G;
          if (NWG % F.G != 0 && (int)blockIdx.x >= NWG % F.G) { const int wi_ = ((int)blockIdx.x - NWG % F.G) * NWAVES + F.wave, nw_ = nidle * NWAVES;
              if (MK_SSMTAIL) { LAS float* scr_ = (LAS float*)(F.lds + RING_OFF + F.wave * 16640); for (int it = wi_; it < NG * 33; it += nw_) p0_ssm_item<7>(F, it / 33, it % 33, scr_); }
              mlp_weight_items(F, wi_, nw_, 0, MK_W1TAIL); }
          else if (NWG % F.G == 0) { if (MK_SSMTAIL) { LAS float* scr_ = (LAS float*)(F.lds + RING_OFF + F.wave * 16640); for (int it = gw; it < NG * 33; it += NGW) p0_ssm_item<7>(F, it / 33, it % 33, scr_); } mlp_weight_items(F, gw, NGW, 0, 4096); } }
        } if (BOTH(2)) GRID_BAR();
    }
    if (IN(3)) { RELOAD_IN(); for (int rep_ = 0; rep_ < ((MK_DUP == 3) ? 2 : 1); ++rep_) {
        for (int un = F.vcu; un < NG * BATCH; un += F.G) ssm_fused_block(F, un);
        attn_phase<15>(F); if (MK_SUB == 32) attn_phase<MK_AMODE>(F);
        late_weight_items(F, gw, NGW); mlp_weight_items(F, gw, NGW, MK_W1TAIL, 8192);
        } if (IN(3) && IN(6)) GRID_BAR();
    }
    if (IN(6)) { RELOAD_IN(); for (int rep_ = 0; rep_ < ((MK_DUP == 6) ? 2 : 1); ++rep_) {
        for (int m = 2 * gw; m < M; m += 2 * NGW) att_combine_rows(F, m);
        pg8::Gemm g{(const pg8::bf16_t*)(ws + WS_YBUF), (const pg8::bf16_t*)(ws + WS_WGLU), M, NGLU_PAD, NU}; pg8::StaticOrder S; S.init(M, NGLU_PAD, F.G, (int)blockIdx.x);
        pg8::EpiGlu E{(pg8::bf16_t*)(ws + WS_AOUT), (const pg8::bf16_t*)(ws + WS_YBUF), F.in[IN_BGLU], (float*)(ws + WS_PGLU)};
        pg8::gemm_phase<pg8::EpiGlu, pg8::StaticOrder, PG8_ALIGN, PG8_SP2>(F.lds + RING_OFF, g, S, E);
        } if (BOTH(6)) GRID_BAR();
    }
    if (IN(7)) { RELOAD_IN(); for (int rep_ = 0; rep_ < ((MK_DUP == 7) ? 2 : 1); ++rep_) {
        pg8::Gemm g{(const pg8::bf16_t*)(ws + WS_AOUT), (const pg8::bf16_t*)(ws + WS_WOUT), M, D, KOUT}; pg8::StaticOrder S; S.init(M, D, F.G, (int)blockIdx.x); S.wgm = MK_WGM7;
        typedef pg8::EpiGen<0, true, 14> Ep; Ep E{(pg8::bf16_t*)(ws + WS_MIX), D, (float*)(ws + WS_POUT), 32, (const float*)(ws + WS_PGLU), 1.0f / NU, EPS};
        pg8::gemm_phase<Ep, pg8::StaticOrder, PG8_ALIGN, PG8_SP2>(F.lds + RING_OFF, g, S, E);
        } if (BOTH(7)) GRID_BAR();
    }
    if (IN(8)) { RELOAD_IN(); for (int rep_ = 0; rep_ < ((MK_DUP == 8) ? 2 : 1); ++rep_) { for (int bc = F.vcu; bc < M / 64; bc += F.G) p8_block(F, bc); } if (BOTH(8)) GRID_BAR(); }
    if (MK_SUB == 99 && !MK_PER_PHASE) { for (int i_ = 0; i_ < 10; ++i_) GRID_BAR(); }
    if (IN(9)) { RELOAD_IN(); for (int rep_ = 0; rep_ < ((MK_DUP == 9) ? 2 : 1); ++rep_) {
        pg8::Gemm g{(const pg8::bf16_t*)(ws + WS_H), (const pg8::bf16_t*)(ws + WS_W1), M, FF, D}; pg8::StaticOrder S; S.init(M, FF, F.G, (int)blockIdx.x); S.wgm = MK_WGM9;
        typedef pg8::EpiGen<2, false, 0, MK_NT9> Ep; Ep E{(pg8::bf16_t*)(ws + WS_HID), FF, nullptr, 0, nullptr, 0.f, 0.f};
        if (MK_SUB == 91) { for (int r_ = 0; r_ < 8; ++r_) { S.r0 = r_; S.nr = 1; pg8::gemm_phase<Ep, pg8::StaticOrder, PG8_ALIGN, PG8_SP2>(F.lds + RING_OFF, g, S, E); if (r_ < 7) GRID_BAR(); } }
        else pg8::gemm_phase<Ep, pg8::StaticOrder, PG8_ALIGN, PG8_SP2>(F.lds + RING_OFF, g, S, E);
        if (MK_GPROBE > 0) pg8::gemm_phase<Ep, pg8::StaticOrder, PG8_ALIGN, PG8_SP2, MK_GPROBE>(F.lds + RING_OFF, g, S, E);
        } if (BOTH(9)) GRID_BAR();
    }
    if (IN(10)) { RELOAD_IN(); for (int rep_ = 0; rep_ < ((MK_DUP == 10) ? 2 : 1); ++rep_) {
        pg8::Gemm g{(const pg8::bf16_t*)(ws + WS_HID), (const pg8::bf16_t*)(ws + WS_W2), M, D, FF}; pg8::StaticOrder S; S.init(M, D, F.G, (int)blockIdx.x); S.wgm = MK_WGM10; S.rev = MK_REV10;
        typedef pg8::EpiGen<0, true, 0> Ep; Ep E{(pg8::bf16_t*)(ws + WS_H), D, (float*)(ws + WS_PY2), 32, nullptr, 0.f, 0.f};
        pg8::gemm_phase<Ep, pg8::StaticOrder, PG8_ALIGN, PG8_SP2, 0, MK_AUX10>(F.lds + RING_OFF, g, S, E);
        } if (BOTH(10)) GRID_BAR();
    }
    if (IN(11)) { RELOAD_IN(); for (int rep_ = 0; rep_ < ((MK_DUP == 11) ? 2 : 1); ++rep_) { for (int bc = F.vcu; bc < M / 64; bc += F.G) p11_block(F, bc); } }
#undef IN
#undef BOTH
}

extern "C" void kernel_launch(void* const* d_in, const int* in_sizes, int n_in, void* d_out, int out_size, void* d_ws, size_t ws_size, hipStream_t stream) {
    static int grid = 0;
    if (grid == 0) {
        if (n_in != 25 || in_sizes[0] != M * D || out_size != M * D || ws_size < WS_END) { fprintf(stderr, "kernel_launch: unexpected shapes: n_in %d in0 %d out %d ws %zu (need %zu)\n", n_in, n_in > 0 ? in_sizes[0] : -1, out_size, ws_size, (size_t)WS_END); grid = -1; return; }
        int dev = 0, cus = 0, per_cu = 0;
        if (hipGetDevice(&dev) != hipSuccess || hipDeviceGetAttribute(&cus, hipDeviceAttributeMultiprocessorCount, dev) != hipSuccess) { fprintf(stderr, "kernel_launch: device query failed\n"); grid = -1; return; }
        if (hipFuncSetAttribute((const void*)mk_fwd, hipFuncAttributeMaxDynamicSharedMemorySize, LDS_BYTES) != hipSuccess) { fprintf(stderr, "kernel_launch: hipFuncSetAttribute failed\n"); grid = -1; return; }
        if (hipOccupancyMaxActiveBlocksPerMultiprocessor(&per_cu, (const void*)mk_fwd, NWAVES * 64, LDS_BYTES) != hipSuccess || per_cu < 1) { fprintf(stderr, "kernel_launch: occupancy query reports %d blocks per CU\n", per_cu); }
        (void)hipGetLastError();
        grid = cus;
    }
    if (grid < 0) return;
    if (hipMemsetAsync((char*)d_ws + WS_CTL, 0, CTL_ZERO_BYTES, stream) != hipSuccess) { fprintf(stderr, "kernel_launch: memset failed\n"); return; }
    Args a{};
    for (int i = 0; i < 25; ++i) a.in[i] = (const float*)d_in[i];
    a.out = (float*)d_out; a.ws = (unsigned char*)d_ws;
#if MK_PER_PHASE
    for (int p = 0; p < N_PHASES; ++p) { a.ph_lo = p; a.ph_hi = p + 1; a.li = p; hipLaunchKernelGGL(mk_fwd, dim3(grid), dim3(NWAVES * 64), LDS_BYTES, stream, a); }
#else
    a.ph_lo = 0; a.ph_hi = N_PHASES; a.li = 0;
    hipLaunchKernelGGL(mk_fwd, dim3(grid), dim3(NWAVES * 64), LDS_BYTES, stream, a);
#endif
    const hipError_t le = hipPeekAtLastError();
    if (le != hipSuccess) fprintf(stderr, "kernel_launch: launch failed: %s\n", hipGetErrorName(le));
}
```

```cpp
#include <hip/hip_runtime.h>
#include <cstdio>
#include <cstdint>
#include <cmath>
#ifndef MK_SEAM
#define MK_SEAM 1
#endif
#ifndef MK_PRIO
#define MK_PRIO 1
#endif
#ifndef MK_STATICPRIO
#define MK_STATICPRIO 0
#endif
namespace pg8 {
#define PG8_LAS __attribute__((address_space(3)))
typedef unsigned short bf16_t;
typedef short bf16x8 __attribute__((ext_vector_type(8)));
typedef float f32x4 __attribute__((ext_vector_type(4)));
typedef unsigned u32x4 __attribute__((ext_vector_type(4)));
constexpr int BM = 256, BK = 64, HALF = 128, HTB = HALF * BK * 2  , STAGE_BYTES = 8 * HTB, NXCD = 8, WGM = 8;

__host__ __device__ __forceinline__ int lds_byte(int r, int c) { const int st = (r >> 4) * 2 + (c >> 5), rr = r & 15, cc = c & 31, ob = rr * 64 + cc * 2; return st * 1024 + (ob ^ (((ob >> 9) & 1) << 5)); }
__host__ __device__ __forceinline__ void stage_rc(int b, int& R, int& C) { const int st = b / 1024, sb = b % 1024, swz = sb ^ (((sb >> 9) & 1) << 5); R = (st >> 1) * 16 + swz / 64; C = (st & 1) * 32 + (swz % 64) / 2; }
__host__ __device__ __forceinline__ int perm32(int rho) { const int n = rho >> 4, i = rho & 15; return 8 * (i >> 2) + 4 * n + (i & 3); }

struct Unit { int pm, pn; };
struct Gemm { const bf16_t* A; const bf16_t* Bt; int M, N, K; };

struct StaticOrder {
    int nM, nN, nwg, G, c, r0 = 0, nr = 1 << 30, wgm = WGM, rev = 0;
    __host__ __device__ void init(int M, int N, int G_, int c_) { nM = M / BM; nN = N / BM; nwg = nM * nN; G = G_; c = c_; }
    __host__ __device__ bool next(int i, Unit& u) const {
        if (i >= nr) return false;
        const int nrounds = (nwg + G - 1) / G; const int ii = rev ? nrounds - 1 - (i + r0) : i + r0; if (ii < 0) return false;
        const long L = (long)ii * G + c; if (L >= nwg) return false;
        int wgid = (int)L; { const int q = nwg / NXCD, r = nwg % NXCD, xcd = wgid % NXCD, off = wgid / NXCD; wgid = (xcd < r ? xcd * (q + 1) : r * (q + 1) + (xcd - r) * q) + off; }
        const int nig = wgm * nN, gid = wgid / nig, fm = gid * wgm, gsz = (nM - fm) < wgm ? (nM - fm) : wgm;
        u.pm = fm + ((wgid % nig) % gsz); u.pn = (wgid % nig) / gsz; return true;
    }
    __device__ __forceinline__ void a_ready(const Unit&) const {}
    __device__ __forceinline__ void done(const Unit&) const {}
};

__device__ __forceinline__ unsigned cvt_pk_bf16(float lo, float hi) { unsigned r; asm volatile("v_cvt_pk_bf16_f32 %0, %1, %2" : "=v"(r) : "v"(lo), "v"(hi)); return r; }
__device__ __forceinline__ float bf_lo(unsigned w) { return __uint_as_float(w << 16); }
__device__ __forceinline__ float bf_hi(unsigned w) { return __uint_as_float(w & 0xffff0000u); }

typedef float f32x2 __attribute__((ext_vector_type(2)));
__device__ __forceinline__ float relu_nc(float x) { float r; asm("v_max_f32_e32 %0, 0, %1" : "=v"(r) : "v"(x)); return r; }
template <int ACT  , bool STATS, int MID, int NT = 0  > struct EpiGen {
    static constexpr bool PERM = true, AFTER_DRAIN = false; static constexpr int MID_T = MID;
    bf16_t* O; int ldc; float* stats; int nstat; const float* midpart; float mid_inv_n, eps;
    __device__ __forceinline__ void mid(f32x4 (&acc)[2][2][4][2], const Unit& u, int wr, int wc, int fr, int fq) const {
        int row0 = u.pm * BM + wr * 64 + fr; asm volatile("" : "+v"(row0));
        const float* mp = midpart + (size_t)row0 * 16 + 4 * fq;
#pragma unroll
        for (int ai = 0; ai < 2; ++ai)
#pragma unroll
            for (int m = 0; m < 4; ++m) { const f32x4 a = *(const f32x4*)(mp + (ai * HALF + m * 16) * 16);
                float ss = (a[0] + a[1]) + (a[2] + a[3]); ss += __shfl_xor(ss, 16); ss += __shfl_xor(ss, 32);
                const float rs = 1.0f / sqrtf(ss * mid_inv_n + eps);
                asm volatile("" ::: "memory");
#pragma unroll
                for (int bj = 0; bj < 2; ++bj)
#pragma unroll
                    for (int n = 0; n < 2; ++n) acc[ai][bj][m][n] = acc[ai][bj][m][n] * rs; }
    }
    __device__ __forceinline__ void operator()(const f32x4 (&acc)[2][2][4][2], const Unit& u, int wr, int wc, int fr, int fq) const {
        const int row0 = u.pm * BM + wr * 64 + fr; const int col0 = u.pn * BM + wc * 32 + 8 * fq;
#pragma unroll
        for (int ai = 0; ai < 2; ++ai)
#pragma unroll
            for (int m = 0; m < 4; ++m) { const int row = row0 + ai * HALF + m * 16; bf16_t* rowp = O + (size_t)row * ldc + col0; float ss = 0.f;
#pragma unroll
                for (int bj = 0; bj < 2; ++bj) { f32x4 v0 = acc[ai][bj][m][0], v1 = acc[ai][bj][m][1];
                    if (ACT == 2) {
#pragma unroll
                        for (int i = 0; i < 4; i += 2) { f32x2 a = { relu_nc(v0[i]), relu_nc(v0[i + 1]) }, b = { relu_nc(v1[i]), relu_nc(v1[i + 1]) }; a = a * a; b = b * b;
                            v0[i] = a.x; v0[i + 1] = a.y; v1[i] = b.x; v1[i + 1] = b.y; } }
                    if (STATS) ss += ((v0[0] * v0[0] + v0[1] * v0[1]) + (v0[2] * v0[2] + v0[3] * v0[3])) + ((v1[0] * v1[0] + v1[1] * v1[1]) + (v1[2] * v1[2] + v1[3] * v1[3]));
                    u32x4 w; w.x = cvt_pk_bf16(v0[0], v0[1]); w.y = cvt_pk_bf16(v0[2], v0[3]); w.z = cvt_pk_bf16(v1[0], v1[1]); w.w = cvt_pk_bf16(v1[2], v1[3]);
                    if (NT == 1) __builtin_nontemporal_store(w, (u32x4*)(rowp + bj * HALF));
                    else if (NT == 2) { const bf16_t* sp = rowp + bj * HALF; asm volatile("global_store_dwordx4 %0, %1, off sc1\n\ts_nop 1" :: "v"(sp), "v"(w) : "memory"); }
                    else *(u32x4*)(rowp + bj * HALF) = w; }
                if (STATS) { ss += __shfl_xor(ss, 16); ss += __shfl_xor(ss, 32); if (fq == 0) stats[(size_t)row * nstat + u.pn * 4 + wc] = ss; } }
    }
};

struct EpiProj {
    static constexpr bool PERM = true, AFTER_DRAIN = false; static constexpr int MID_T = 0;
    bf16_t* O; const float* rope; float qscale; bf16_t* UT;
    __device__ __forceinline__ void mid(f32x4 (&)[2][2][4][2], const Unit&, int, int, int, int) const {}
    template <int K0, int K1> __device__ __forceinline__ void body(const f32x4 (&acc)[2][2][4][2], const Unit& u, int wr, int wc, int fr, int fq) const {
        const int row0 = u.pm * BM + wr * 64 + fr; const int col0 = u.pn * BM + wc * 32 + 8 * fq;
        constexpr bool anyrope = (K0 < 2) || (K1 < 2);
        const bool ropelane = (fq < 2) && ((wc & 1) == 0);
        const float sg = (fq == 0) ? -1.0f : 1.0f;
#pragma unroll
        for (int am = 0; am < 4; ++am) { const int ai = am >> 1;
            f32x4 rc[4][4];
            if constexpr (anyrope) {
#pragma unroll
                for (int m = 2 * (am & 1); m < 2 * (am & 1) + 2; ++m) { const f32x4* rp = (const f32x4*)(rope + (size_t)(row0 + ai * HALF + m * 16) * 16); rc[m][0] = rp[0]; rc[m][1] = rp[1]; rc[m][2] = rp[2]; rc[m][3] = rp[3]; } }
#pragma unroll
            for (int m = 2 * (am & 1); m < 2 * (am & 1) + 2; ++m) { const int row = row0 + ai * HALF + m * 16; bf16_t* rowp = O + (size_t)row * 2816 + col0;
#pragma unroll
                for (int bj = 0; bj < 2; ++bj) { constexpr int dummy = 0; (void)dummy; const int kind = bj == 0 ? K0 : K1;
                    f32x4 v0 = acc[ai][bj][m][0], v1 = acc[ai][bj][m][1];
                    if (kind < 2) {
                        f32x4 o0, o1;
#pragma unroll
                        for (int i = 0; i < 4; ++i) {
                            const auto ra = __builtin_amdgcn_permlane16_swap(__float_as_uint(v0[i]), __float_as_uint(v0[i]), false, false);
                            const auto rb = __builtin_amdgcn_permlane16_swap(__float_as_uint(v1[i]), __float_as_uint(v1[i]), false, false);
                            o0[i] = __uint_as_float((fq & 1) ? ra[0] : ra[1]); o1[i] = __uint_as_float((fq & 1) ? rb[0] : rb[1]); }
                        const f32x4 r0 = v0 * rc[m][0] + (o0 * rc[m][2]) * sg, r1 = v1 * rc[m][1] + (o1 * rc[m][3]) * sg;
#pragma unroll
                        for (int i = 0; i < 4; ++i) { v0[i] = ropelane ? r0[i] : v0[i]; v1[i] = ropelane ? r1[i] : v1[i]; }
                        if (kind == 0) { v0 = v0 * qscale; v1 = v1 * qscale; }
                    }
                    u32x4 w; w.x = cvt_pk_bf16(v0[0], v0[1]); w.y = cvt_pk_bf16(v0[2], v0[3]); w.z = cvt_pk_bf16(v1[0], v1[1]); w.w = cvt_pk_bf16(v1[2], v1[3]);
                    if (kind < 3) *(u32x4*)(rowp + bj * HALF) = w;
                    else { const int cu = col0 + bj * HALF - 1920; *(u32x4*)(UT + ((size_t)(cu >> 4) * 16384 + row) * 16 + (cu & 15)) = w; } } } }
    }
    __device__ __forceinline__ void operator()(const f32x4 (&acc)[2][2][4][2], const Unit& u, int wr, int wc, int fr, int fq) const {
        if (u.pn < 4) body<0, 0>(acc, u, wr, wc, fr, fq); else if (u.pn == 4) body<0, 1>(acc, u, wr, wc, fr, fq); else if (u.pn == 5) body<1, 1>(acc, u, wr, wc, fr, fq);
        else if (u.pn == 6) body<2, 2>(acc, u, wr, wc, fr, fq); else if (u.pn == 7) body<2, 3>(acc, u, wr, wc, fr, fq); else body<3, 3>(acc, u, wr, wc, fr, fq);
    }
};

struct EpiGlu {
    static constexpr bool PERM = true, AFTER_DRAIN = false; static constexpr int MID_T = 0;
    bf16_t* O; const bf16_t* Y; const float* bias; float* stats;
    __device__ __forceinline__ void mid(f32x4 (&)[2][2][4][2], const Unit&, int, int, int, int) const {}
    template <int NBJ> __device__ __forceinline__ void body(const f32x4 (&acc)[2][2][4][2], const Unit& u, int wr, int wc, int fr, int fq) const {
        const int row0 = u.pm * BM + wr * 64 + fr; const int col0 = u.pn * BM + wc * 32 + 8 * fq;
        f32x4 bv[NBJ][2]; u32x4 yv[2][4][NBJ];
#pragma unroll
        for (int bj = 0; bj < NBJ; ++bj)
#pragma unroll
            for (int n = 0; n < 2; ++n) bv[bj][n] = *(const f32x4*)(bias + col0 + bj * HALF + 4 * n);
#pragma unroll
        for (int ai = 0; ai < 2; ++ai)
#pragma unroll
            for (int m = 0; m < 4; ++m)
#pragma unroll
                for (int bj = 0; bj < NBJ; ++bj) yv[ai][m][bj] = *(const u32x4*)(Y + (size_t)(row0 + ai * HALF + m * 16) * 896 + col0 + bj * HALF);
#pragma unroll
        for (int ai = 0; ai < 2; ++ai)
#pragma unroll
            for (int m = 0; m < 4; ++m) { const int row = row0 + ai * HALF + m * 16; float ss = 0.f;
#pragma unroll
                for (int bj = 0; bj < NBJ; ++bj) { const int col = col0 + bj * HALF;
                    const f32x4 z0 = acc[ai][bj][m][0] + bv[bj][0], z1 = acc[ai][bj][m][1] + bv[bj][1];
                    const u32x4 yw = yv[ai][m][bj];
                    float y[8] = {bf_lo(yw.x), bf_hi(yw.x), bf_lo(yw.y), bf_hi(yw.y), bf_lo(yw.z), bf_hi(yw.z), bf_lo(yw.w), bf_hi(yw.w)};
                    float s[8];
#pragma unroll
                    for (int i = 0; i < 4; ++i) { s[i] = y[i] * __builtin_amdgcn_rcpf(1.0f + __builtin_amdgcn_exp2f(-1.4426950408889634f * z0[i])); s[4 + i] = y[4 + i] * __builtin_amdgcn_rcpf(1.0f + __builtin_amdgcn_exp2f(-1.4426950408889634f * z1[i])); }
#pragma unroll
                    for (int i = 0; i < 8; ++i) ss += s[i] * s[i];
                    u32x4 w; w.x = cvt_pk_bf16(s[0], s[1]); w.y = cvt_pk_bf16(s[2], s[3]); w.z = cvt_pk_bf16(s[4], s[5]); w.w = cvt_pk_bf16(s[6], s[7]);
                    *(u32x4*)(O + (size_t)row * 1280 + col) = w; }
                ss += __shfl_xor(ss, 16); ss += __shfl_xor(ss, 32); if (fq == 0) stats[(size_t)row * 16 + u.pn * 4 + wc] = ss; }
    }
    __device__ __forceinline__ void operator()(const f32x4 (&acc)[2][2][4][2], const Unit& u, int wr, int wc, int fr, int fq) const {
        if (u.pn < 3) body<2>(acc, u, wr, wc, fr, fq); else body<1>(acc, u, wr, wc, fr, fq);
    }
};

template <class Epi, class Sched, bool ALIGN_EPI = false, bool SP2 = false, int PROBE = 0  , int AUXA = 0  >
__device__ __forceinline__ void gemm_phase(PG8_LAS unsigned char* lds, const Gemm g, const Sched& S, const Epi& E) {
    const int tid = threadIdx.x, wid = __builtin_amdgcn_readfirstlane(tid >> 6), lane = tid & 63, wr = wid >> 2, wc = wid & 3, fr = lane & 15, fq = lane >> 4;
    const int K = g.K, nt = K / BK;
    unsigned voffA[2], voffB[2];
#pragma unroll
    for (int i = 0; i < 2; ++i) { int R, C; stage_rc(tid * 16 + i * 8192, R, C); const int Rb = Epi::PERM ? ((R & ~31) + perm32(R & 31)) : R;
        voffA[i] = (unsigned)(R * K + C) * 2u; voffB[i] = (unsigned)(Rb * K + C) * 2u; }
    const size_t kstep = (size_t)(BK * 2);
    const size_t hstep = (size_t)HALF * K * 2;
    const size_t tstep = 2 * hstep;
    const unsigned ldsw = (unsigned)wid * 1024u;
    const int aoff = lds_byte(wr * 64 + fr, fq * 8), boff = lds_byte(wc * 32 + fr, fq * 8);
#define PG8_SA(b, h) (((b) * 2 + (h)) * HTB)
#define PG8_SB(b, h) ((4 + (b) * 2 + (h)) * HTB)
#define PG8_STAGE(bufoff, gbase, voff) do { if (!(PROBE & 2)) _Pragma("unroll") for (int _i = 0; _i < 2; ++_i) \
        __builtin_amdgcn_global_load_lds((const unsigned*)((const char*)(gbase) + (voff)[_i]), (PG8_LAS unsigned*)(lds + (bufoff) + ldsw + _i * 8192), 16, 0, 0); } while (0)
#define PG8_STAGEA(bufoff, gbase, voff) do { if (!(PROBE & 2)) _Pragma("unroll") for (int _i = 0; _i < 2; ++_i) \
        __builtin_amdgcn_global_load_lds((const unsigned*)((const char*)(gbase) + (voff)[_i]), (PG8_LAS unsigned*)(lds + (bufoff) + ldsw + _i * 8192), 16, 0, AUXA); } while (0)
#define PG8_LDA(dst, b, h) do { if (!(PROBE & 8)) _Pragma("unroll") for (int m = 0; m < 4; ++m) _Pragma("unroll") for (int k = 0; k < 2; ++k) dst[m][k] = *(const PG8_LAS bf16x8*)(lds + PG8_SA(b, h) + aoff + m * 2048 + k * 1024); } while (0)
#define PG8_LDB(dst, b, h) do { if (!(PROBE & 8)) _Pragma("unroll") for (int n = 0; n < 2; ++n) _Pragma("unroll") for (int k = 0; k < 2; ++k) dst[n][k] = *(const PG8_LAS bf16x8*)(lds + PG8_SB(b, h) + boff + n * 2048 + k * 1024); } while (0)
#define PG8_MMA(ai, bj, At, Bt) do { if (!MK_STATICPRIO) __builtin_amdgcn_s_setprio(MK_PRIO); if (!(PROBE & 1)) _Pragma("unroll") for (int m = 0; m < 4; ++m) _Pragma("unroll") for (int n = 0; n < 2; ++n) _Pragma("unroll") for (int k = 0; k < 2; ++k) \
        acc[ai][bj][m][n] = __builtin_amdgcn_mfma_f32_16x16x32_bf16(Bt[n][k], At[m][k], acc[ai][bj][m][n], 0, 0, 0); if (!MK_STATICPRIO) __builtin_amdgcn_s_setprio(0); } while (0)
#define PG8_WAIT_V(n) asm volatile("s_waitcnt vmcnt(" #n ")" ::: "memory")
#define PG8_WAIT_L(n) asm volatile("s_waitcnt lgkmcnt(" #n ")" ::: "memory")
#define PG8_BAR __builtin_amdgcn_s_barrier()
#define PG8_SCHED __builtin_amdgcn_sched_barrier(0)
    Unit cur, nxt; int ui = 0;
    if (!S.next(0, cur)) return;
    if (MK_STATICPRIO) { if (wid >= 4) __builtin_amdgcn_s_setprio(1); }
    f32x4 acc[2][2][4][2];
#pragma unroll
    for (int a = 0; a < 2; ++a)
#pragma unroll
        for (int b = 0; b < 2; ++b)
#pragma unroll
            for (int m = 0; m < 4; ++m)
#pragma unroll
                for (int n = 0; n < 2; ++n) acc[a][b][m][n] = (f32x4){0.f, 0.f, 0.f, 0.f};
    bf16x8 At[4][2], B0[2][2], B1[2][2];
    if constexpr ((PROBE & 8) != 0) {
#pragma unroll
        for (int m = 0; m < 4; ++m)
#pragma unroll
            for (int k = 0; k < 2; ++k) asm volatile("" : "=v"(At[m][k]));
#pragma unroll
        for (int n = 0; n < 2; ++n)
#pragma unroll
            for (int k = 0; k < 2; ++k) { asm volatile("" : "=v"(B0[n][k])); asm volatile("" : "=v"(B1[n][k])); } }
    const char* cA = (const char*)g.A + (size_t)((PROBE & 16) ? 0 : cur.pm) * tstep; const char* cB = (const char*)g.Bt + (size_t)((PROBE & 16) ? 0 : cur.pn) * tstep;
    S.a_ready(cur);
    if constexpr (SP2) {
        PG8_STAGE(PG8_SB(0, 0), cB, voffB); PG8_STAGE(PG8_SB(0, 1), cB + hstep, voffB); PG8_STAGEA(PG8_SA(0, 0), cA, voffA); PG8_STAGEA(PG8_SA(0, 1), cA + hstep, voffA);
        if (wr == 1) PG8_BAR;
        PG8_WAIT_V(2); PG8_BAR;
        PG8_STAGE(PG8_SB(1, 0), cB + kstep, voffB); PG8_STAGEA(PG8_SA(1, 0), cA + kstep, voffA); PG8_STAGE(PG8_SB(1, 1), cB + hstep + kstep, voffB);
        PG8_WAIT_V(6); PG8_BAR;
    } else {
        PG8_STAGE(PG8_SB(0, 0), cB, voffB); PG8_STAGEA(PG8_SA(0, 0), cA, voffA); PG8_STAGE(PG8_SB(0, 1), cB + hstep, voffB); PG8_STAGEA(PG8_SA(0, 1), cA + hstep, voffA);
        if (wr == 1) PG8_BAR;
        PG8_WAIT_V(4); PG8_BAR;
        PG8_STAGE(PG8_SB(1, 0), cB + kstep, voffB); PG8_STAGEA(PG8_SA(1, 0), cA + kstep, voffA); PG8_STAGE(PG8_SB(1, 1), cB + hstep + kstep, voffB);
        PG8_WAIT_V(6); PG8_BAR;
    }
    for (;;) {
        const bool has_next = S.next(ui + 1, nxt);
        const char* nA = (has_next && !(PROBE & 16)) ? (const char*)g.A + (size_t)nxt.pm * tstep : cA; const char* nB = (has_next && !(PROBE & 16)) ? (const char*)g.Bt + (size_t)nxt.pn * tstep : cB;
        for (int t = 0; t < nt; t += 2) {
            if constexpr (Epi::MID_T > 0) { if (t == Epi::MID_T) E.mid(acc, cur, wr, wc, fr, fq); }
            const bool last = (t == nt - 2);
            const char* a1 = cA + (size_t)(t + 1) * kstep;
            const char* a2 = last ? nA : cA + (size_t)(t + 2) * kstep; const char* b2 = last ? nB : cB + (size_t)(t + 2) * kstep;
            const char* a3 = a2 + kstep; const char* b3 = b2 + kstep;
            if (last && has_next) S.a_ready(nxt);
            if constexpr (SP2) {
            PG8_LDB(B0, 0, 0); PG8_LDB(B1, 0, 1); PG8_SCHED; PG8_LDA(At, 0, 0); PG8_STAGEA(PG8_SA(1, 1), a1 + hstep, voffA);
            PG8_WAIT_V(8); PG8_WAIT_L(0); PG8_BAR; PG8_MMA(0, 0, At, B0); PG8_MMA(0, 1, At, B1); PG8_BAR; PG8_SCHED;
            PG8_LDA(At, 0, 1); PG8_STAGE(PG8_SB(0, 0), b2, voffB); PG8_STAGE(PG8_SB(0, 1), b2 + hstep, voffB); PG8_STAGEA(PG8_SA(0, 0), a2, voffA);
            PG8_WAIT_V(8); PG8_WAIT_L(0); PG8_BAR; PG8_MMA(1, 0, At, B0); PG8_MMA(1, 1, At, B1); PG8_BAR; PG8_SCHED;
            PG8_LDB(B0, 1, 0); PG8_LDB(B1, 1, 1); PG8_SCHED; PG8_LDA(At, 1, 0); PG8_STAGEA(PG8_SA(0, 1), a2 + hstep, voffA);
            PG8_WAIT_V(8); PG8_WAIT_L(0); PG8_BAR; PG8_MMA(0, 0, At, B0); PG8_MMA(0, 1, At, B1); PG8_BAR; PG8_SCHED;
            PG8_LDA(At, 1, 1); PG8_STAGE(PG8_SB(1, 0), b3, voffB); PG8_STAGE(PG8_SB(1, 1), b3 + hstep, voffB); PG8_STAGEA(PG8_SA(1, 0), a3, voffA);
            PG8_WAIT_V(8); PG8_WAIT_L(0); PG8_BAR; PG8_MMA(1, 0, At, B0); PG8_MMA(1, 1, At, B1); PG8_BAR; PG8_SCHED;
            } else {
            PG8_LDB(B0, 0, 0); PG8_SCHED; PG8_LDA(At, 0, 0); PG8_STAGEA(PG8_SA(1, 1), a1 + hstep, voffA);
            PG8_WAIT_L(8); PG8_BAR; PG8_WAIT_L(0); PG8_MMA(0, 0, At, B0); PG8_BAR; PG8_SCHED;
            PG8_LDB(B1, 0, 1); PG8_STAGE(PG8_SB(0, 0), b2, voffB);
            PG8_BAR; PG8_WAIT_L(0); PG8_MMA(0, 1, At, B1); PG8_BAR;
            PG8_LDA(At, 0, 1); PG8_STAGEA(PG8_SA(0, 0), a2, voffA);
            PG8_BAR; PG8_WAIT_L(0); PG8_MMA(1, 0, At, B0); PG8_BAR; PG8_SCHED;
            PG8_STAGE(PG8_SB(0, 1), b2 + hstep, voffB);
            PG8_WAIT_V(6); PG8_BAR; PG8_MMA(1, 1, At, B1); PG8_BAR;
            PG8_LDB(B0, 1, 0); PG8_SCHED; PG8_LDA(At, 1, 0); PG8_STAGEA(PG8_SA(0, 1), a2 + hstep, voffA);
            PG8_WAIT_L(8); PG8_BAR; PG8_WAIT_L(0); PG8_MMA(0, 0, At, B0); PG8_BAR; PG8_SCHED;
            PG8_LDB(B1, 1, 1); PG8_STAGE(PG8_SB(1, 0), b3, voffB);
            PG8_BAR; PG8_WAIT_L(0); PG8_MMA(0, 1, At, B1); PG8_BAR;
            PG8_LDA(At, 1, 1); PG8_STAGEA(PG8_SA(1, 0), a3, voffA);
            PG8_BAR; PG8_WAIT_L(0); PG8_MMA(1, 0, At, B0); PG8_BAR; PG8_SCHED;
            PG8_STAGE(PG8_SB(1, 1), b3 + hstep, voffB);
            PG8_WAIT_V(6); PG8_BAR; PG8_MMA(1, 1, At, B1); PG8_BAR;
            }
        }
        if constexpr (ALIGN_EPI) { if (wr == 0) PG8_BAR; }
        if constexpr (!Epi::AFTER_DRAIN) { if constexpr (PROBE & 4) { _Pragma("unroll") for (int a_ = 0; a_ < 2; ++a_) _Pragma("unroll") for (int b_ = 0; b_ < 2; ++b_) _Pragma("unroll") for (int m_ = 0; m_ < 4; ++m_) _Pragma("unroll") for (int n_ = 0; n_ < 2; ++n_) asm volatile("" :: "v"(acc[a_][b_][m_][n_])); } else { E(acc, cur, wr, wc, fr, fq); } S.done(cur); }
        if (!has_next) break;
#pragma unroll
        for (int a = 0; a < 2; ++a)
#pragma unroll
            for (int b = 0; b < 2; ++b)
#pragma unroll
                for (int m = 0; m < 4; ++m)
#pragma unroll
                    for (int n = 0; n < 2; ++n) acc[a][b][m][n] = (f32x4){0.f, 0.f, 0.f, 0.f};
        cur = nxt; cA = nA; cB = nB; ++ui;
        if constexpr (ALIGN_EPI) { if (wr == 1) PG8_BAR; }
    }
    if (MK_STATICPRIO) __builtin_amdgcn_s_setprio(0);
    PG8_WAIT_V(0);
    if constexpr (!ALIGN_EPI) { if (wr == 0) PG8_BAR; }
    PG8_BAR;
    if constexpr (Epi::AFTER_DRAIN) { E.fused(acc, cur, wr, wc, fr, fq, lds, wid, lane); S.done(cur); }
#undef PG8_SA
#undef PG8_SB
#undef PG8_STAGE
#undef PG8_STAGEA
#undef PG8_LDA
#undef PG8_LDB
#undef PG8_MMA
#undef PG8_WAIT_V
#undef PG8_WAIT_L
#undef PG8_BAR
#undef PG8_SCHED
}
}

#ifndef PG8_SP2
#define PG8_SP2 true
#endif
#ifndef PG8_ALIGN
#define PG8_ALIGN true
#endif
#ifndef MK_PER_PHASE
#define MK_PER_PHASE 0
#endif

#ifndef MK_P0SUB
#define MK_P0SUB 0
#endif
#ifndef MK_P0MODE
#define MK_P0MODE 7
#endif
#ifndef MK_SUB
#define MK_SUB 0
#endif
#ifndef MK_CMODE
#define MK_CMODE 7
#endif
#ifndef MK_GPROBE
#define MK_GPROBE 0
#endif
#ifndef MK_NT9
#define MK_NT9 0
#endif
#ifndef MK_W1TAIL
#define MK_W1TAIL 4096
#endif
#ifndef MK_AMODE
#define MK_AMODE 15
#endif
#ifndef MK_P1G
#define MK_P1G 53
#endif
#ifndef MK_NTLD
#define MK_NTLD 3
#endif
#ifndef MK_AUX10
#define MK_AUX10 0
#endif
#ifndef MK_WGM10
#define MK_WGM10 4
#endif
#ifndef MK_WGM9
#define MK_WGM9 4
#endif
#ifndef MK_WGM7
#define MK_WGM7 4
#endif
#ifndef MK_WGM2
#define MK_WGM2 4
#endif
#ifndef MK_REV10
#define MK_REV10 1
#endif
#ifndef MK_P1BAL
#define MK_P1BAL 0
#endif
#ifndef MK_SSMTAIL
#define MK_SSMTAIL 0
#endif
#ifndef MK_LOCALBAR
#define MK_LOCALBAR 1
#endif
#ifndef MK_DUP
#define MK_DUP -1
#endif

constexpr int NWAVES = 8;
constexpr int BATCH = 4, SEQ = 4096, M = BATCH * SEQ, D = 2048;
constexpr int NQ = 1152, NKV = 384, NU = 896, NIN = 2816, COL_K = 1152, COL_V = 1536, COL_U = 1920;
constexpr int KOUT = 1280, FF = 8192, NMOD = 6 * D;
constexpr int NG = 56, NST = 64, NCH = 16, LC = 32, NCOL = M / LC;
constexpr int NGLU_PAD = 1024;
constexpr float EPS = 1e-6f;
constexpr float QSCALE = 0.125f * 1.4426950408889634f;
constexpr int N_PHASES = 12;

constexpr size_t MiB = 1u << 20;
constexpr size_t WS_CTL = 0, CTL_ZERO_BYTES = 32 * 1024;
constexpr size_t WS_MOD = 1 * MiB;
constexpr size_t WS_AL = 1 * MiB + 256 * 1024;
constexpr size_t WS_ROPE = 2 * MiB;
constexpr size_t WS_KT = 3 * MiB;
constexpr size_t WS_WET = 4 * MiB;
constexpr size_t WS_G = 11 * MiB;
constexpr size_t WS_WIN = 18 * MiB;
constexpr size_t WS_WGLU = 29 * MiB;
constexpr size_t WS_WOUT = 31 * MiB;
constexpr size_t WS_W1 = 36 * MiB;
constexpr size_t WS_W2 = 68 * MiB;
constexpr size_t WS_H = 448 * MiB;
constexpr size_t WS_MIX = 384 * MiB;
constexpr size_t WS_PGLU = 356 * MiB;
constexpr size_t WS_POUT = 357 * MiB;
constexpr size_t WS_PY2 = 359 * MiB;
constexpr size_t WS_LSE = 320 * MiB;
constexpr size_t WS_PROJ = 100 * MiB;
constexpr size_t WS_E = 362 * MiB;
constexpr size_t WS_CARRY = 362 * MiB;
constexpr size_t WS_OBUF = 216 * MiB;
constexpr size_t WS_YBUF = 252 * MiB;
constexpr size_t WS_AOUT = 280 * MiB;
constexpr size_t WS_UT = 188 * MiB;
constexpr size_t WS_HID = 100 * MiB;
constexpr size_t WS_END = 512 * MiB;
static_assert(WS_PROJ + (size_t)M * NIN * 2 <= WS_UT && WS_UT + (size_t)M * NU * 2 <= WS_OBUF && WS_OBUF + (size_t)3 * M * NKV * 2 <= WS_YBUF && WS_YBUF + (size_t)M * NU * 2 <= WS_AOUT && WS_AOUT + (size_t)M * KOUT * 2 <= WS_LSE &&
              WS_LSE + (size_t)3 * M * 8 * 4 <= WS_PGLU && WS_HID + (size_t)M * FF * 2 <= WS_PGLU && WS_PY2 + (size_t)M * 32 * 4 <= WS_MIX && WS_MIX + (size_t)M * D * 2 <= WS_H && WS_H + (size_t)M * D * 2 <= WS_END && WS_W2 + (size_t)D * FF * 2 <= WS_HID, "d_ws map");
constexpr int CW_TMO = 0, CW_CODE = 1, CW_GEMV = 64, CW_XTAB = 512  , CW_BAR = 4096;
static_assert((CW_BAR + 3456) * 4 <= (int)CTL_ZERO_BYTES, "control words inside the memset region");

constexpr int LDS_BYTES_C = 147456;
constexpr int RING_OFF = 0, RING_BYTES = 131072;
constexpr int LDSCTL_OFF = 8 * 16640  , MISC_OFF = LDSCTL_OFF + 320;
static_assert(LDSCTL_OFF >= RING_BYTES && MISC_OFF + 128 <= LDS_BYTES_C, "LDS map");
constexpr int LDS_BYTES = 147456;

#define GAS __attribute__((address_space(1)))
#define LAS __attribute__((address_space(3)))
typedef unsigned short bf16;
typedef unsigned v4u __attribute__((ext_vector_type(4)));
typedef float f32x4 __attribute__((ext_vector_type(4)));
typedef short bf16x8 __attribute__((ext_vector_type(8)));
typedef GAS unsigned gu32;
typedef GAS unsigned long long gu64;
#define RLX_AGENT __ATOMIC_RELAXED, __HIP_MEMORY_SCOPE_AGENT
#define LDS_WAIT() asm volatile("s_waitcnt lgkmcnt(0)" ::: "memory")
#define VM_WAIT() asm volatile("s_waitcnt vmcnt(0)" ::: "memory")
__device__ __forceinline__ unsigned long long rt() { return __builtin_amdgcn_s_memrealtime(); }
__device__ __forceinline__ unsigned f2bf(float f) { unsigned u = __builtin_bit_cast(unsigned, f); return (u + 0x7fffu + ((u >> 16) & 1u)) >> 16; }
__device__ __forceinline__ unsigned pk2(float lo, float hi) { return f2bf(lo) | (f2bf(hi) << 16); }

#define XB_TMO      128
#define XB_XCNT(j)  (256  + 64 * (j))
#define XB_XSUB(j)  (1280 + 64 * (j))
#define XB_XGEN(j)  (2304 + 64 * (j))
#define XB_TOP      3328
#define XB_TOPGEN   3392
#define XCD_BAR_WORDS 3456
#define XB_SPIN_CAP (1u << 18)

__device__ __forceinline__ unsigned xb_ld(unsigned* p)              { return __hip_atomic_load(p, __ATOMIC_RELAXED, __HIP_MEMORY_SCOPE_AGENT); }
__device__ __forceinline__ unsigned xb_add(unsigned* p, unsigned v) { return __hip_atomic_fetch_add(p, v, __ATOMIC_RELAXED, __HIP_MEMORY_SCOPE_AGENT); }
__device__ __forceinline__ unsigned xb_xcc_id() { return (unsigned)__builtin_amdgcn_s_getreg((3 << 11) | 20) & 0xFu; }
#define XB_SPIN(cond, bar) do { unsigned _sp = 0; while (cond) { __builtin_amdgcn_s_sleep(1); \
    if ((++_sp & 255u) == 0u) { if (xb_ld(&(bar)[XB_TMO])) break; if (_sp > XB_SPIN_CAP) { atomicAdd(&(bar)[XB_TMO], 1u); break; } } } } while (0)

struct XcdBarrier {
    unsigned* bar; unsigned x;
    volatile LAS unsigned* st;
};

__device__ __forceinline__ XcdBarrier xcd_barrier_post(unsigned* bar, volatile LAS unsigned* st) {
    XcdBarrier b; b.bar = bar; b.x = xb_xcc_id(); b.st = st;
    if (threadIdx.x == 0) (void)xb_add(&bar[XB_XCNT(b.x)], 1u);
    return b;
}
__device__ __forceinline__ void xcd_barrier_complete(unsigned* bar, unsigned x, unsigned& nloc, unsigned& nx) {
    const unsigned G = gridDim.x * gridDim.y * gridDim.z;
    unsigned sum, cnt, mine, sp = 0u;
    for (;;) {
        sum = 0u; cnt = 0u; mine = 0u;
#pragma unroll
        for (unsigned j = 0; j < 16; ++j) { const unsigned c = xb_ld(&bar[XB_XCNT(j)]); sum += c; cnt += (c > 0u) ? 1u : 0u; mine = (j == x) ? c : mine; }
        if (sum == G) break;
        __builtin_amdgcn_s_sleep(1);
        if ((++sp & 255u) == 0u) { if (xb_ld(&bar[XB_TMO])) break; if (sp > XB_SPIN_CAP) { atomicAdd(&bar[XB_TMO], 1u); break; } }
    }
    nloc = mine > 0u ? mine : 1u; nx = cnt > 0u ? cnt : 1u;
}

__device__ __forceinline__ void xcd_barrier(const XcdBarrier& b) {
    asm volatile("s_waitcnt vmcnt(0)" ::: "memory");
    __syncthreads();
    if (threadIdx.x == 0) {
        unsigned* bar = b.bar;
        __builtin_amdgcn_s_waitcnt(0);
        unsigned nloc = b.st[0], nx = b.st[1];
        if (nloc == 0u) { xcd_barrier_complete(bar, b.x, nloc, nx); b.st[0] = nloc; b.st[1] = nx; }
        const unsigned old = xb_add(&bar[XB_XSUB(b.x)], 1u);
        const unsigned gen = old / nloc;
        if (old + 1u == (gen + 1u) * nloc) {
            __builtin_amdgcn_fence(__ATOMIC_RELEASE, "agent");
            asm volatile("s_waitcnt vmcnt(0)" ::: "memory");
            const unsigned og = xb_add(&bar[XB_TOP], 1u);
            const unsigned tg = og / nx;
            if (og + 1u == (tg + 1u) * nx) xb_add(&bar[XB_TOPGEN], 1u);
            else XB_SPIN(xb_ld(&bar[XB_TOPGEN]) == tg, bar);
            __builtin_amdgcn_fence(__ATOMIC_ACQUIRE, "agent");
            xb_add(&bar[XB_XGEN(b.x)], 1u);
            asm volatile("s_waitcnt vmcnt(0)" ::: "memory");
        } else {
            XB_SPIN(xb_ld(&bar[XB_XGEN(b.x)]) == gen, bar);
            __builtin_amdgcn_fence(__ATOMIC_ACQUIRE, "agent");
            asm volatile("s_waitcnt vmcnt(0)" ::: "memory");
        }
    }
    __syncthreads();
}

#define XL_SUB(j) (1024 + 64 * (j))
#define XL_GEN(j) (2048 + 64 * (j))
__device__ __forceinline__ void xcc_local_barrier(const XcdBarrier& b, unsigned* ctl) {
    asm volatile("s_waitcnt vmcnt(0)" ::: "memory");
    __syncthreads();
    if (threadIdx.x == 0) {
        __builtin_amdgcn_s_waitcnt(0);
        const unsigned nloc = b.st[0];
        const unsigned old = xb_add(&ctl[XL_SUB(b.x)], 1u);
        const unsigned gen = old / nloc;
        if (old + 1u == (gen + 1u) * nloc) xb_add(&ctl[XL_GEN(b.x)], 1u);
        else XB_SPIN(xb_ld(&ctl[XL_GEN(b.x)]) == gen, b.bar);
        __builtin_amdgcn_fence(__ATOMIC_ACQUIRE, "agent");
        asm volatile("s_waitcnt vmcnt(0)" ::: "memory");
    }
    __syncthreads();
}

typedef float f32x16 __attribute__((ext_vector_type(16)));
typedef unsigned u32x4 __attribute__((ext_vector_type(4)));
typedef short s16x4 __attribute__((ext_vector_type(4)));
typedef unsigned u32x2 __attribute__((ext_vector_type(2)));
typedef const float* const __attribute__((address_space(4)))* KARGP;
struct Frame {
    LAS unsigned char* lds;
    volatile LAS unsigned* MISC;
    gu32* ctl;
    int tid, lane, wave;
    int vcu, G;
    KARGP in; float* out; unsigned char* ws;
};
#define IN_X 0
#define IN_C 1
#define IN_POS 2
#define IN_WADA 3
#define IN_BADA 4
#define IN_GPREMIX 5
#define IN_GPOSTMIX 6
#define IN_WIN 7
#define IN_ARE 8
#define IN_AIM 9
#define IN_LOGDT 10
#define IN_BRE 11
#define IN_BIM 12
#define IN_CRE 13
#define IN_CIM 14
#define IN_SSMD 15
#define IN_WGLU 16
#define IN_BGLU 17
#define IN_GATT 18
#define IN_GSSM 19
#define IN_WOUT 20
#define IN_GPREMLP 21
#define IN_GPOSTMLP 22
#define IN_W1 23
#define IN_W2 24

__device__ __forceinline__ float wave_sum(float v) {
#pragma unroll
    for (int o = 1; o < 64; o <<= 1) v += __shfl_xor(v, o);
    return v;
}
__device__ __forceinline__ int crow(int r, int hi) { return (r & 3) + 8 * (r >> 2) + 4 * hi; }


__device__ __forceinline__ void sincos_red(double x, double& s, double& c) {
    double rev = x * 0.15915494309189535; rev -= rint(rev);
    sincospi(2.0 * rev, &s, &c);
}

__device__ __forceinline__ void p0_transpose_item(const float* W, int N, bf16* WT, int ldk, LAS float* scr, int k0, int n0, int kdst, const float* gain, int lane) {
    const int cq = lane & 15, rs = lane >> 4;
    f32x4 v[16];
#pragma unroll
    for (int i = 0; i < 16; ++i) v[i] = MK_NTLD ? __builtin_nontemporal_load((const GAS f32x4*)(W + (size_t)(k0 + 4 * i + rs) * N + n0 + 4 * cq)) : *(const GAS f32x4*)(W + (size_t)(k0 + 4 * i + rs) * N + n0 + 4 * cq);
    if (gain) {
#pragma unroll
        for (int i = 0; i < 16; ++i) v[i] = v[i] * gain[4 * i + rs]; }
#pragma unroll
    for (int i = 0; i < 16; ++i) { LAS float* d = scr + (4 * i + rs) * 65 + 4 * cq; d[0] = v[i].x; d[1] = v[i].y; d[2] = v[i].z; d[3] = v[i].w; }
    LDS_WAIT(); asm volatile("" ::: "memory");
    const int c = lane & 7;
#pragma unroll
    for (int j = 0; j < 8; ++j) { const int n = (lane >> 3) + 8 * j; const LAS float* s = scr + (8 * c) * 65 + n;
        v4u o; o.x = pk2(s[0 * 65], s[1 * 65]); o.y = pk2(s[2 * 65], s[3 * 65]); o.z = pk2(s[4 * 65], s[5 * 65]); o.w = pk2(s[6 * 65], s[7 * 65]);
        *(GAS v4u*)(WT + (size_t)(n0 + n) * ldk + kdst + 8 * c) = o; }
    LDS_WAIT(); asm volatile("" ::: "memory");
}

template <int MODE  > __device__ __forceinline__ void p0_ssm_item(Frame& F, int g, int k, LAS float* scr) {
    const int n = F.lane;
    const double dt = exp((double)F.in[IN_LOGDT][g]);
    const double lr = (double)F.in[IN_ARE][g * 64 + n], li = (double)F.in[IN_AIM][g * 64 + n];
    const double zr = lr * dt, zi = li * dt;
    double s1, c1; sincos_red(zi, s1, c1);
    const double er = exp(zr), ar = er * c1, ai = er * s1;
    const double den = lr * lr + li * li;
    const double cfr = ((ar - 1.0) * lr + ai * li) / den, cfi = (ai * lr - (ar - 1.0) * li) / den;
    double sk, ck; sincos_red(zi * (double)k, sk, ck);
    const double ek = exp(zr * (double)k), pr_d = ek * ck, pi_d = ek * sk;
    const float pr = (float)pr_d, pi = (float)pi_d;
    bf16* KT = (bf16*)(F.ws + WS_KT); bf16* WET = (bf16*)(F.ws + WS_WET); bf16* GT = (bf16*)(F.ws + WS_G);
    const float vr = (float)(pr_d * cfr - pi_d * cfi), vi = (float)(pr_d * cfi + pi_d * cfr);
    const float* bre = F.in[IN_BRE] + (size_t)(g * 64 + n) * 16; const float* bim = F.in[IN_BIM] + (size_t)(g * 64 + n) * 16;
    float br[16], bi[16];
#pragma unroll
    for (int q = 0; q < 4; ++q) { const f32x4 a = ((const f32x4*)bre)[q], b = ((const f32x4*)bim)[q];
#pragma unroll
        for (int e = 0; e < 4; ++e) { br[4 * q + e] = a[e]; bi[4 * q + e] = b[e]; } }
    float crv[16], civ[16];
    { const float* cre = F.in[IN_CRE] + (size_t)g * 1024 + n; const float* cim = F.in[IN_CIM] + (size_t)g * 1024 + n;
#pragma unroll
      for (int p = 0; p < 16; ++p) { crv[p] = cre[p * 64]; civ[p] = cim[p * 64]; } }
    if (k == 32) {
        float* AL = (float*)(F.ws + WS_AL); AL[(g * 64 + n) * 2] = pr; AL[(g * 64 + n) * 2 + 1] = pi;
        unsigned* z = (unsigned*)(KT + (size_t)(g * 33) * 256); z[n] = 0u; z[n + 64] = 0u;
    }
    if ((MODE & 1) && k <= 31) {
        const int sg = 31 - k;
        unsigned wre[8], wim[8];
#pragma unroll
        for (int q = 0; q < 8; ++q) { const float r0 = vr * br[2 * q] - vi * bi[2 * q], r1 = vr * br[2 * q + 1] - vi * bi[2 * q + 1];
            const float i0 = vr * bi[2 * q] + vi * br[2 * q], i1 = vr * bi[2 * q + 1] + vi * br[2 * q + 1]; wre[q] = pk2(r0, r1); wim[q] = pk2(i0, i1); }
        v4u* wb = (v4u*)WET + (size_t)g * 4 * 32 * 64 + (size_t)sg * 64 + (n & 31);
        v4u* dre = wb + (size_t)(n >> 5) * 32 * 64; v4u* dim = wb + (size_t)(2 + (n >> 5)) * 32 * 64;
        dre[0] = (v4u){wre[0], wre[1], wre[2], wre[3]}; dre[32] = (v4u){wre[4], wre[5], wre[6], wre[7]};
        dim[0] = (v4u){wim[0], wim[1], wim[2], wim[3]}; dim[32] = (v4u){wim[4], wim[5], wim[6], wim[7]};
    }
    if ((MODE & 2) && k >= 1) {
#pragma unroll
        for (int p = 0; p < 16; ++p) { const float gr = crv[p] * pr - civ[p] * pi, gi = -(crv[p] * pi + civ[p] * pr);
            bf16* gb = GT + ((size_t)(g * 16 + ((k - 1) >> 1)) * 8 * 64 + (((k - 1) & 1) * 16 + p)) * 8;
            gb[((size_t)(n >> 4) * 64 + ((n >> 3) & 1) * 32) * 8 + (n & 7)] = (bf16)f2bf(gr); gb[((size_t)(4 + (n >> 4)) * 64 + ((n >> 3) & 1) * 32) * 8 + (n & 7)] = (bf16)f2bf(gi); }
    }
    if ((MODE & 4) && k <= 31) {
#pragma unroll
        for (int q = 0; q < 4; ++q) { f32x4 a, b;
#pragma unroll
            for (int e = 0; e < 4; ++e) { a[e] = crv[4 * q + e] * vr - civ[4 * q + e] * vi; b[e] = -(crv[4 * q + e] * vi + civ[4 * q + e] * vr); }
            *(LAS f32x4*)(scr + n * 16 + 4 * q) = a; *(LAS f32x4*)(scr + (64 + n) * 16 + 4 * q) = b;
            *(LAS f32x4*)(scr + 2048 + n * 16 + 4 * q) = (f32x4){br[4 * q], br[4 * q + 1], br[4 * q + 2], br[4 * q + 3]};
            *(LAS f32x4*)(scr + 2048 + (64 + n) * 16 + 4 * q) = (f32x4){bi[4 * q], bi[4 * q + 1], bi[4 * q + 2], bi[4 * q + 3]}; }
        LDS_WAIT(); asm volatile("" ::: "memory");
        f32x4 acc = {0.f, 0.f, 0.f, 0.f};
#pragma unroll 8
        for (int t = 0; t < 32; ++t) acc = __builtin_amdgcn_mfma_f32_16x16x4f32(scr[t * 64 + n], scr[2048 + t * 64 + n], acc, 0, 0, 0);
        const int pp = n & 15, p0 = 4 * (n >> 4);
#pragma unroll
        for (int r = 0; r < 4; ++r) { float mine = acc[r]; if (k == 0 && pp == p0 + r) mine += F.in[IN_SSMD][g * 16 + pp];
            KT[((size_t)(g * 33 + k + 1) * 16 + p0 + r) * 16 + pp] = (bf16)f2bf(mine); }
        LDS_WAIT(); asm volatile("" ::: "memory");
    }
}

__device__ __forceinline__ void p1_row(Frame& F, int m) {
    const int b = m >> 12; const float* mod = (const float*)(F.ws + WS_MOD) + (size_t)b * NMOD;
    const GAS f32x4* xr = (const GAS f32x4*)(F.in[IN_X] + (size_t)m * D) + F.lane;
    f32x4 v[8]; float s = 0.f;
#pragma unroll
    for (int j = 0; j < 8; ++j) { v[j] = (MK_NTLD & 2) ? __builtin_nontemporal_load(xr + 64 * j) : xr[64 * j]; s += (v[j].x * v[j].x + v[j].y * v[j].y) + (v[j].z * v[j].z + v[j].w * v[j].w); }
    const float rstd = 1.0f / sqrtf(wave_sum(s) * (1.f / D) + EPS);
    GAS unsigned long long* o8 = (GAS unsigned long long*)((bf16*)(F.ws + WS_H) + (size_t)m * D) + F.lane;
#pragma unroll
    for (int j = 0; j < 8; ++j) { const int c = 4 * F.lane + 256 * j;
        const f32x4 g = *(const f32x4*)(F.in[IN_GPREMIX] + c), sh = *(const f32x4*)(mod + c), sc = *(const f32x4*)(mod + D + c);
        const f32x4 h = v[j] * rstd * g * (sc + 1.0f) + sh;
        const unsigned long long hv = (unsigned long long)pk2(h.x, h.y) | ((unsigned long long)pk2(h.z, h.w) << 32); if (MK_NTLD & 16) __builtin_nontemporal_store(hv, o8 + 64 * j); else o8[64 * j] = hv; }
}

struct RowX { f32x4 x[8]; u32x2 a[8]; float part; };
__device__ __forceinline__ void row_load(Frame& F, RowX& R, int m, const bf16* abuf, const float* parts) {
    const GAS f32x4* xr = (const GAS f32x4*)(F.in[IN_X] + (size_t)m * D) + F.lane; const GAS u32x2* ar = (const GAS u32x2*)(abuf + (size_t)m * D) + F.lane;
#pragma unroll
    for (int j = 0; j < 8; ++j) { R.x[j] = (MK_NTLD & 2) ? __builtin_nontemporal_load(xr + 64 * j) : xr[64 * j]; R.a[j] = (MK_NTLD & 8) ? __builtin_nontemporal_load(ar + 64 * j) : ar[64 * j]; }
    R.part = F.lane < 32 ? parts[(size_t)m * 32 + F.lane] : 0.f;
}
__device__ __forceinline__ f32x4 bf4(u32x2 w) { return (f32x4){pg8::bf_lo(w.x), pg8::bf_hi(w.x), pg8::bf_lo(w.y), pg8::bf_hi(w.y)}; }
__device__ __forceinline__ void p8_block(Frame& F, int bc) {
    const int b = (bc * 64) >> 12; const float* mod = (const float*)(F.ws + WS_MOD) + (size_t)b * NMOD;
    LAS f32x4* C = (LAS f32x4*)(F.lds + RING_OFF);
    __syncthreads();
    { const int c = 4 * F.tid; C[F.tid] = *(const f32x4*)(mod + 2 * D + c) * *(const f32x4*)(F.in[IN_GPOSTMIX] + c);
      C[512 + F.tid] = *(const f32x4*)(F.in[IN_GPREMLP] + c) * (*(const f32x4*)(mod + 4 * D + c) + 1.0f); C[1024 + F.tid] = *(const f32x4*)(mod + 3 * D + c); }
    LDS_WAIT(); __syncthreads();
    const int m0 = bc * 64 + F.wave * 8;
    const bf16* mix = (const bf16*)(F.ws + WS_MIX); const float* parts = (const float*)(F.ws + WS_POUT);
    RowX cur, nxt; row_load(F, cur, m0, mix, parts);
#pragma unroll 1
    for (int r = 0; r < 8; ++r) {
        row_load(F, nxt, m0 + (r < 7 ? r + 1 : 7), mix, parts);
        const float rs_mix = 1.0f / sqrtf(wave_sum(cur.part) * (1.f / D) + EPS);
        float s = 0.f;
#pragma unroll
        for (int j = 0; j < 8; ++j) { const f32x4 v = cur.x[j] + C[F.lane + 64 * j] * (bf4(cur.a[j]) * rs_mix); cur.x[j] = v; s += (v.x * v.x + v.y * v.y) + (v.z * v.z + v.w * v.w); }
        const float rstd = 1.0f / sqrtf(wave_sum(s) * (1.f / D) + EPS);
        GAS unsigned long long* o8 = (GAS unsigned long long*)((bf16*)(F.ws + WS_H) + (size_t)(m0 + r) * D) + F.lane;
#pragma unroll
        for (int j = 0; j < 8; ++j) { const f32x4 h = cur.x[j] * rstd * C[512 + F.lane + 64 * j] + C[1024 + F.lane + 64 * j]; o8[64 * j] = (unsigned long long)pk2(h.x, h.y) | ((unsigned long long)pk2(h.z, h.w) << 32); }
        cur = nxt;
    }
}
__device__ __forceinline__ void p11_block(Frame& F, int bc) {
    const int b = (bc * 64) >> 12; const float* mod = (const float*)(F.ws + WS_MOD) + (size_t)b * NMOD;
    LAS f32x4* C = (LAS f32x4*)(F.lds + RING_OFF);
    __syncthreads();
    { const int c = 4 * F.tid; C[F.tid] = *(const f32x4*)(mod + 2 * D + c) * *(const f32x4*)(F.in[IN_GPOSTMIX] + c); C[512 + F.tid] = *(const f32x4*)(mod + 5 * D + c) * *(const f32x4*)(F.in[IN_GPOSTMLP] + c); }
    LDS_WAIT(); __syncthreads();
    const int m0 = bc * 64 + F.wave * 8;
    const bf16* mix = (const bf16*)(F.ws + WS_MIX); const float* parts = (const float*)(F.ws + WS_POUT);
    const bf16* y2 = (const bf16*)(F.ws + WS_H); const float* parts2 = (const float*)(F.ws + WS_PY2);
    RowX cur, nxt; u32x2 ycur[8], ynxt[8]; float pcur, pnxt = 0.f;
    row_load(F, cur, m0, mix, parts);
    { const GAS u32x2* yr = (const GAS u32x2*)(y2 + (size_t)m0 * D) + F.lane;
#pragma unroll
      for (int j = 0; j < 8; ++j) ycur[j] = (MK_NTLD & 8) ? __builtin_nontemporal_load(yr + 64 * j) : yr[64 * j];
      pcur = F.lane < 32 ? parts2[(size_t)m0 * 32 + F.lane] : 0.f; }
#pragma unroll 1
    for (int r = 0; r < 8; ++r) {
        { const int mn = m0 + (r < 7 ? r + 1 : 7); row_load(F, nxt, mn, mix, parts); const GAS u32x2* yr = (const GAS u32x2*)(y2 + (size_t)mn * D) + F.lane;
#pragma unroll
            for (int j = 0; j < 8; ++j) ynxt[j] = (MK_NTLD & 8) ? __builtin_nontemporal_load(yr + 64 * j) : yr[64 * j];
            pnxt = F.lane < 32 ? parts2[(size_t)mn * 32 + F.lane] : 0.f; }
        const float rs1 = 1.0f / sqrtf(wave_sum(cur.part) * (1.f / D) + EPS), rs2 = 1.0f / sqrtf(wave_sum(pcur) * (1.f / D) + EPS);
        GAS f32x4* orow = (GAS f32x4*)(F.out + (size_t)(m0 + r) * D) + F.lane;
#pragma unroll
        for (int j = 0; j < 8; ++j) { const f32x4 ov = cur.x[j] + C[F.lane + 64 * j] * (bf4(cur.a[j]) * rs1) + C[512 + F.lane + 64 * j] * (bf4(ycur[j]) * rs2); if (MK_NTLD & 4) __builtin_nontemporal_store(ov, orow + 64 * j); else orow[64 * j] = ov; }
        cur = nxt; pcur = pnxt;
#pragma unroll
        for (int j = 0; j < 8; ++j) ycur[j] = ynxt[j];
    }
}

__device__ __forceinline__ bf16x8 ld8(const bf16* p) { return *(const bf16x8*)p; }
__device__ __forceinline__ s16x4 vtr(LAS const unsigned char* p) { typedef short v4i16_t __attribute__((ext_vector_type(4))); return __builtin_bit_cast(s16x4, __builtin_amdgcn_ds_read_tr16_b64_v4i16((LAS v4i16_t*)p)); }
constexpr int ATT_UNITS = BATCH * 6 * 3 * 16, ATT_V = 49152;
struct AttU { int hh, g, dsh, res, i0; size_t rowb; };
__device__ __forceinline__ AttU att_decode(int u) { AttU a; const int b = u / 288; int rem = u - b * 288; a.hh = rem / 48; rem -= a.hh * 48; a.g = rem >> 4; const int blk = rem & 15;
    a.dsh = 2 * a.g; const int nb = 16 >> a.dsh; a.res = blk / nb; a.i0 = (blk - a.res * nb) * 256; a.rowb = (size_t)b * SEQ; return a; }
__device__ __forceinline__ int att_unit_of(Frame& F, int k) {
    if (F.G == 256) { if (k < 4) return F.vcu + 256 * k; if (F.vcu >= NG * BATCH && k < 8) return 1024 + (F.vcu - NG * BATCH) + 32 * (k - 4); return ATT_UNITS; }
    const int u = F.vcu + k * F.G; return u < ATT_UNITS ? u : ATT_UNITS;
}
__device__ __forceinline__ void att_issue(Frame& F, const AttU& a, u32x4 (&kv)[12], bf16x8 (&qn)[4]) {
    const bf16* proj = (const bf16*)(F.ws + WS_PROJ);
#pragma unroll
    for (int i = 0; i < 6; ++i) { const int ck = F.tid + 512 * i, row = ck >> 3, ch = ck & 7; int kidx = a.i0 - 128 + row; kidx = kidx < 0 ? 0 : kidx;
        const bf16* rp = proj + (a.rowb + ((size_t)kidx << a.dsh) + a.res) * NIN + a.hh * 64 + ch * 8;
        kv[i] = *(const u32x4*)(rp + COL_K); kv[6 + i] = *(const u32x4*)(rp + COL_V); }
    const bf16* qp = proj + (a.rowb + ((size_t)(a.i0 + 32 * F.wave + (F.lane & 31)) << a.dsh) + a.res) * NIN + (a.g * 6 + a.hh) * 64 + (F.lane >> 5) * 8;
#pragma unroll
    for (int kk = 0; kk < 4; ++kk) qn[kk] = ld8(qp + 16 * kk);
}
template <int MODE  > __device__ __forceinline__ void attn_phase(Frame& F) {
    const int lane = F.lane, r32 = lane & 31, hi = lane >> 5, w = F.wave;
    LAS unsigned char* L = F.lds + RING_OFF;
    u32x4 kv[12]; bf16x8 qn[4];
    int k_ = 0; int u = att_unit_of(F, 0);
    if (u < ATT_UNITS) { const AttU a = att_decode(u); att_issue(F, a, kv, qn); }
    int kch[4];
#pragma unroll
    for (int kk = 0; kk < 4; ++kk) kch[kk] = (32 * w + r32) * 128 + (((2 * kk + hi) ^ (r32 & 7)) * 16);
    const int grp = lane >> 4, tq = (grp >> 1) * 4 + ((lane & 15) >> 2), tp = lane & 3;
    int vch[2];
#pragma unroll
    for (int dt = 0; dt < 2; ++dt) vch[dt] = ATT_V + (32 * w + tq) * 128 + (((4 * dt + 2 * (grp & 1) + (tp >> 1)) ^ (tq & 7)) * 16) + 8 * (tp & 1);
    while (u < ATT_UNITS) {
        const AttU a = att_decode(u);
        __syncthreads();
#pragma unroll
        for (int i = 0; i < 6; ++i) { const int ck = F.tid + 512 * i, row = ck >> 3, ch = ck & 7; const int off = row * 128 + ((ch ^ (row & 7)) * 16);
            *(LAS u32x4*)(L + off) = kv[i]; *(LAS u32x4*)(L + ATT_V + off) = kv[6 + i]; }
        bf16x8 qf[4];
#pragma unroll
        for (int kk = 0; kk < 4; ++kk) qf[kk] = qn[kk];
        LDS_WAIT(); __syncthreads();
        const int un = att_unit_of(F, ++k_);
        if (un < ATT_UNITS) { const AttU an = att_decode(un); att_issue(F, an, kv, qn); }
        const int iq = a.i0 + 32 * w;
        const int jmin = (iq >= 128) ? 0 : (128 - iq) >> 5;
        f32x16 S[5];
#pragma unroll
        for (int j = 0; j < 5; ++j) S[j] = (f32x16){};
        if (MODE & 1) {
            bf16x8 kf[4][5];
#pragma unroll
            for (int j = 0; j < 5; ++j) kf[0][j] = *(const LAS bf16x8*)(L + kch[0] + j * 4096);
#pragma unroll
            for (int kk = 0; kk < 4; ++kk) {
                if (kk < 3) {
#pragma unroll
                    for (int j = 0; j < 5; ++j) kf[kk + 1][j] = *(const LAS bf16x8*)(L + kch[kk + 1] + j * 4096); }
                __builtin_amdgcn_sched_barrier(0);
#pragma unroll
                for (int j = 0; j < 5; ++j) S[j] = __builtin_amdgcn_mfma_f32_32x32x16_bf16(kf[kk][j], qf[kk], S[j], 0, 0, 0);
                __builtin_amdgcn_sched_barrier(0);
            } }
        const float NEG = -INFINITY; float mx = NEG, l = 1.f;
        if (MODE & 2) {
#pragma unroll
        for (int r = 0; r < 16; ++r) { const int bb = crow(r, hi); if (bb < r32) S[0][r] = NEG; if (bb > r32) S[4][r] = NEG; }
#pragma unroll
        for (int j = 0; j < 4; ++j) if (j < jmin) {
#pragma unroll
            for (int r = 0; r < 16; ++r) S[j][r] = NEG; }
        { float m0 = NEG, m1 = NEG;
#pragma unroll
          for (int j = 0; j < 5; ++j)
#pragma unroll
              for (int r = 0; r < 16; r += 4) { m0 = fmaxf(fmaxf(m0, S[j][r]), S[j][r + 1]); m1 = fmaxf(fmaxf(m1, S[j][r + 2]), S[j][r + 3]); }
          mx = fmaxf(m0, m1); }
        mx = fmaxf(mx, __shfl_xor(mx, 32));
        l = 0.f;
#pragma unroll
        for (int j = 0; j < 5; ++j)
#pragma unroll
            for (int r = 0; r < 16; ++r) { const float p = __builtin_amdgcn_exp2f(S[j][r] - mx); S[j][r] = p; l += p; }
        l += __shfl_xor(l, 32);
        } else { _Pragma("unroll") for (int j = 0; j < 5; ++j) asm volatile("" : "+v"(S[j])); }
        f32x16 O0 = (f32x16){}, O1 = (f32x16){}, O2 = (f32x16){}, O3 = (f32x16){};
        if (MODE & 4) {
            s16x4 vq[10][4];
#define ATT_VRD(st) do { _Pragma("unroll") for (int dt = 0; dt < 2; ++dt) { vq[st][2 * dt] = vtr(L + vch[dt] + (16 * (st)) * 128); vq[st][2 * dt + 1] = vtr(L + vch[dt] + (16 * (st) + 8) * 128); } } while (0)
            ATT_VRD(0); ATT_VRD(1);
#pragma unroll
            for (int st = 0; st < 10; ++st) {
                const int j = st >> 1, s = st & 1;
                if (st + 2 < 10) ATT_VRD(st + 2);
                bf16x8 pf;
#pragma unroll
                for (int e = 0; e < 8; e += 2) { const unsigned wd = pg8::cvt_pk_bf16(S[j][8 * s + e], S[j][8 * s + e + 1]); pf[e] = (short)(wd & 0xffffu); pf[e + 1] = (short)(wd >> 16); }
                __builtin_amdgcn_sched_barrier(0);
                const bf16x8 vf0 = {vq[st][0][0], vq[st][0][1], vq[st][0][2], vq[st][0][3], vq[st][1][0], vq[st][1][1], vq[st][1][2], vq[st][1][3]};
                const bf16x8 vf1 = {vq[st][2][0], vq[st][2][1], vq[st][2][2], vq[st][2][3], vq[st][3][0], vq[st][3][1], vq[st][3][2], vq[st][3][3]};
                if (s == 0) { O0 = __builtin_amdgcn_mfma_f32_32x32x16_bf16(vf0, pf, O0, 0, 0, 0); O1 = __builtin_amdgcn_mfma_f32_32x32x16_bf16(vf1, pf, O1, 0, 0, 0); }
                else { O2 = __builtin_amdgcn_mfma_f32_32x32x16_bf16(vf0, pf, O2, 0, 0, 0); O3 = __builtin_amdgcn_mfma_f32_32x32x16_bf16(vf1, pf, O3, 0, 0, 0); }
                __builtin_amdgcn_sched_barrier(0);
            }
#undef ATT_VRD
        }
        O0 = O0 + O2; O1 = O1 + O3;
        if (!(MODE & 8)) { asm volatile("" :: "v"(O0), "v"(O1), "v"(mx), "v"(l)); if (!(MODE & 4)) { _Pragma("unroll") for (int j = 0; j < 5; ++j) asm volatile("" :: "v"(S[j])); } u = un; continue; }
        const float il = 1.0f / l;
        const size_t qrow = a.rowb + ((size_t)(iq + r32) << a.dsh) + a.res;
        bf16* ob = (bf16*)(F.ws + WS_OBUF) + ((size_t)a.g * M + qrow) * NKV + a.hh * 64;
#pragma unroll
        for (int t = 0; t < 2; ++t) {
#pragma unroll
            for (int ip = 0; ip < 2; ++ip) {
                const f32x16& O = t == 0 ? O0 : O1;
                const unsigned a0 = pg8::cvt_pk_bf16(O[8 * ip] * il, O[8 * ip + 1] * il), a1 = pg8::cvt_pk_bf16(O[8 * ip + 2] * il, O[8 * ip + 3] * il);
                const unsigned b0 = pg8::cvt_pk_bf16(O[8 * ip + 4] * il, O[8 * ip + 5] * il), b1 = pg8::cvt_pk_bf16(O[8 * ip + 6] * il, O[8 * ip + 7] * il);
                const auto r0 = __builtin_amdgcn_permlane32_swap(a0, b0, false, false), r1 = __builtin_amdgcn_permlane32_swap(a1, b1, false, false);
                u32x4 wv;
                if (hi == 0) { wv.x = a0; wv.y = a1; wv.z = r0[1]; wv.w = r1[1]; } else { wv.x = r0[0]; wv.y = r1[0]; wv.z = b0; wv.w = b1; }
                *(u32x4*)(ob + 32 * t + 16 * ip + 8 * hi) = wv; } }
        if (hi == 0) ((float*)(F.ws + WS_LSE))[((size_t)a.g * M + qrow) * 8 + a.hh] = mx + __builtin_amdgcn_logf(l);
        u = un;
    }
    __syncthreads();
}

__device__ __forceinline__ void att_combine_rows(Frame& F, int m0) {
    const float* lse = (const float*)(F.ws + WS_LSE); const bf16* ob = (const bf16*)(F.ws + WS_OBUF);
    const int l = F.lane < 48 ? F.lane : 47, hd = l >> 3;
    u32x4 o[2][3]; float ls[2][3];
#pragma unroll
    for (int r = 0; r < 2; ++r)
#pragma unroll
        for (int g = 0; g < 3; ++g) { o[r][g] = *(const u32x4*)(ob + ((size_t)g * M + m0 + r) * NKV + 8 * l); ls[r][g] = lse[((size_t)g * M + m0 + r) * 8 + hd]; }
    const f32x4 g0 = *(const f32x4*)(F.in[IN_GATT] + 8 * l), g1 = *(const f32x4*)(F.in[IN_GATT] + 8 * l + 4);
#pragma unroll
    for (int r = 0; r < 2; ++r) {
        const float mx = fmaxf(ls[r][0], fmaxf(ls[r][1], ls[r][2])); const float w0 = __builtin_amdgcn_exp2f(ls[r][0] - mx), w1 = __builtin_amdgcn_exp2f(ls[r][1] - mx), w2 = __builtin_amdgcn_exp2f(ls[r][2] - mx);
        const float inv = 1.0f / (w0 + w1 + w2); const float a0 = w0 * inv, a1 = w1 * inv, a2 = w2 * inv;
        float v[8]; float ss = 0.f;
#pragma unroll
        for (int e = 0; e < 4; ++e) { const unsigned x0 = o[r][0][e], x1 = o[r][1][e], x2 = o[r][2][e];
            v[2 * e] = a0 * pg8::bf_lo(x0) + a1 * pg8::bf_lo(x1) + a2 * pg8::bf_lo(x2); v[2 * e + 1] = a0 * pg8::bf_hi(x0) + a1 * pg8::bf_hi(x1) + a2 * pg8::bf_hi(x2);
            ss += v[2 * e] * v[2 * e] + v[2 * e + 1] * v[2 * e + 1]; }
        if (F.lane >= 48) ss = 0.f;
        const float rstd = 1.0f / sqrtf(wave_sum(ss) * (1.f / NKV) + EPS);
        u32x4 wv; wv.x = pg8::cvt_pk_bf16(v[0] * rstd * g0.x, v[1] * rstd * g0.y); wv.y = pg8::cvt_pk_bf16(v[2] * rstd * g0.z, v[3] * rstd * g0.w);
        wv.z = pg8::cvt_pk_bf16(v[4] * rstd * g1.x, v[5] * rstd * g1.y); wv.w = pg8::cvt_pk_bf16(v[6] * rstd * g1.z, v[7] * rstd * g1.w);
        if (F.lane < 48) *(u32x4*)((bf16*)(F.ws + WS_AOUT) + (size_t)(m0 + r) * KOUT + 896 + 8 * l) = wv;
    }
}

constexpr int SA_E = 66560;
__device__ __forceinline__ float gelu_tanh(float x) { const float u = x * (2.3022082f + 0.1029432f * x * x); return x * __builtin_amdgcn_rcpf(1.0f + __builtin_amdgcn_exp2f(-u)); }
constexpr int SF_CY = 0, SF_U = 34816, SF_KT = 68096, SF_Y = 84992;
__device__ __forceinline__ void ssm_fused_block(Frame& F, int unit) {
    const int tid = F.tid, lane = F.lane, r32 = lane & 31, hi = lane >> 5, w = F.wave;
    const int g = unit >> 2, b = unit & 3;
    LAS unsigned char* L = F.lds + RING_OFF;
    {
        const int rt = w & 3, chf = w >> 2;
        const v4u* ap = (const v4u*)(F.ws + WS_WET) + (size_t)(g * 4 + rt) * 32 * 64 + lane;
        bf16x8 af[32];
#pragma unroll
        for (int sg = 0; sg < 32; ++sg) af[sg] = __builtin_bit_cast(bf16x8, ap[sg * 64]);
#pragma unroll 1
        for (int half = 0; half < 2; ++half) {
            const bf16* ut = (const bf16*)(F.ws + WS_UT) + ((size_t)g * M + b * SEQ + half * 2048) * 16;
            u32x4 su[8];
#pragma unroll
            for (int i = 0; i < 8; ++i) su[i] = *(const u32x4*)(ut + (size_t)(tid + 512 * i) * 8);
#pragma unroll
            for (int i = 0; i < 8; ++i) { const int ch = tid + 512 * i, tok = ch >> 1; *(LAS u32x4*)(L + (tok >> 5) * 1040 + (tok & 31) * 32 + (ch & 1) * 16) = su[i]; }
            LDS_WAIT(); __syncthreads();
            f32x16 acc = (f32x16){}, acc2 = (f32x16){};
            const LAS unsigned char* ub = L + (chf * 32 + r32) * 1040 + hi * 16;
#pragma unroll
            for (int sg = 0; sg < 32; sg += 2) { acc = __builtin_amdgcn_mfma_f32_32x32x16_bf16(af[sg], *(const LAS bf16x8*)(ub + sg * 32), acc, 0, 0, 0);
                                                 acc2 = __builtin_amdgcn_mfma_f32_32x32x16_bf16(af[sg + 1], *(const LAS bf16x8*)(ub + sg * 32 + 32), acc2, 0, 0, 0); }
            acc = acc + acc2;
            LAS float* El = (LAS float*)(L + SA_E) + (half * 64 + chf * 32 + r32) * 128 + rt * 32;
#pragma unroll
            for (int i = 0; i < 4; ++i) *(LAS f32x4*)(El + 8 * i + 4 * hi) = (f32x4){acc[4 * i], acc[4 * i + 1], acc[4 * i + 2], acc[4 * i + 3]};
            LDS_WAIT(); __syncthreads();
        }
    }
    const bf16* utb = (const bf16*)(F.ws + WS_UT) + ((size_t)g * M + b * SEQ) * 16;
    const bf16* KT = (const bf16*)(F.ws + WS_KT) + (size_t)g * 33 * 256;
    u32x4 su[4], sk[3];
#pragma unroll
    for (int i = 0; i < 3; ++i) { const int ch = tid + 512 * i; sk[i] = *(const u32x4*)(KT + (size_t)(ch < 1056 ? ch : 0) * 8); }
#pragma unroll
    for (int i = 0; i < 4; ++i) su[i] = *(const u32x4*)(utb + (size_t)(tid + 512 * i) * 8);
    bf16x8 gf[2][8];
#pragma unroll
    for (int h = 0; h < 2; ++h) { const int tp = h == 0 ? w : 15 - w; const v4u* gp = (const v4u*)(F.ws + WS_G) + (size_t)(g * 16 + tp) * 8 * 64 + lane;
#pragma unroll
        for (int kk = 0; kk < 8; ++kk) gf[h][kk] = __builtin_bit_cast(bf16x8, gp[kk * 64]); }
    if (w == 0) {
        const float* AL = (const float*)(F.ws + WS_AL); const float alr = AL[(g * 64 + lane) * 2], ali = AL[(g * 64 + lane) * 2 + 1];
        const LAS float* El = (const LAS float*)(L + SA_E); LAS bf16* CY = (LAS bf16*)(L + SF_CY);
        float cr = 0.f, ci = 0.f;
#pragma unroll 8
        for (int c = 0; c < 128; ++c) { CY[c * 136 + lane] = (bf16)f2bf(cr); CY[c * 136 + 64 + lane] = (bf16)f2bf(ci);
            const float er = El[c * 128 + lane], ei = El[c * 128 + 64 + lane]; const float nr = alr * cr - ali * ci + er, ni = alr * ci + ali * cr + ei; cr = nr; ci = ni; }
    }
    LDS_WAIT(); __syncthreads();
#pragma unroll
    for (int i = 0; i < 3; ++i) { const int ch = tid + 512 * i; if (ch < 1056) *(LAS u32x4*)(L + SF_KT + ch * 16) = sk[i]; }
    const LAS unsigned char* ub = L + SF_U + r32 * 1040 + hi * 16;
#pragma unroll 1
    for (int cbl = 0; cbl < 4; ++cbl) {
#pragma unroll
        for (int i = 0; i < 4; ++i) { const int ch = tid + 512 * i, tok = ch >> 1; *(LAS u32x4*)(L + SF_U + (tok >> 5) * 1040 + (tok & 31) * 32 + (ch & 1) * 16) = su[i]; }
        LDS_WAIT(); __syncthreads();
        if (cbl < 3) {
#pragma unroll
            for (int i = 0; i < 4; ++i) su[i] = *(const u32x4*)(utb + (size_t)(cbl + 1) * 1024 * 16 + (size_t)(tid + 512 * i) * 8); }
        const LAS unsigned char* cyb = L + SF_CY + (32 * cbl + r32) * 272 + hi * 16;
#pragma unroll
        for (int h = 0; h < 2; ++h) {
            const int tau0 = 2 * (h == 0 ? w : 15 - w);
            f32x16 acc = (f32x16){}, acc2 = (f32x16){};
#pragma unroll
            for (int kk = 0; kk < 8; kk += 2) { acc = __builtin_amdgcn_mfma_f32_32x32x16_bf16(gf[h][kk], *(const LAS bf16x8*)(cyb + 32 * kk), acc, 0, 0, 0);
                                                acc2 = __builtin_amdgcn_mfma_f32_32x32x16_bf16(gf[h][kk + 1], *(const LAS bf16x8*)(cyb + 32 * kk + 32), acc2, 0, 0, 0); }
            const LAS unsigned char* kb = L + SF_KT + (tau0 + 1) * 512 + r32 * 32 + hi * 16;
#pragma unroll 2
            for (int sg = 0; sg < tau0 + 2; sg += 2) {
                acc = __builtin_amdgcn_mfma_f32_32x32x16_bf16(*(const LAS bf16x8*)(kb - sg * 512), *(const LAS bf16x8*)(ub + sg * 32), acc, 0, 0, 0);
                acc2 = __builtin_amdgcn_mfma_f32_32x32x16_bf16(*(const LAS bf16x8*)(kb - (sg + 1) * 512), *(const LAS bf16x8*)(ub + (sg + 1) * 32), acc2, 0, 0, 0); }
            acc = acc + acc2;
#pragma unroll
            for (int i = 0; i < 4; ++i) {
                u32x2 o; o.x = pg8::cvt_pk_bf16(gelu_tanh(acc[4 * i]), gelu_tanh(acc[4 * i + 1])); o.y = pg8::cvt_pk_bf16(gelu_tanh(acc[4 * i + 2]), gelu_tanh(acc[4 * i + 3]));
                *(LAS u32x2*)(L + SF_Y + r32 * 1040 + (tau0 + (i >> 1)) * 32 + (8 * (i & 1) + 4 * hi) * 2) = o; }
        }
        LDS_WAIT(); __syncthreads();
        bf16* yb = (bf16*)(F.ws + WS_YBUF) + ((size_t)b * SEQ + cbl * 1024) * NU + g * 16;
#pragma unroll
        for (int i = 0; i < 4; ++i) { const int ch = tid + 512 * i, tok = ch >> 1;
            *(u32x4*)(yb + (size_t)tok * NU + 8 * (ch & 1)) = *(const LAS u32x4*)(L + SF_Y + (tok >> 5) * 1040 + (tok & 31) * 32 + (ch & 1) * 16); }
    }
    __syncthreads();
}

__device__ __forceinline__ void p0_gemv_item(Frame& F, int item) {
    LAS float* sc = (LAS float*)(F.lds + RING_OFF); LAS float* red = (LAS float*)(F.lds + RING_OFF + 32768);
    const float* W = F.in[IN_WADA]; const int n0 = item * 64;
    const int cg = F.lane & 15, rsub = F.lane >> 4;
    f32x4 acc[4] = {{0.f, 0.f, 0.f, 0.f}, {0.f, 0.f, 0.f, 0.f}, {0.f, 0.f, 0.f, 0.f}, {0.f, 0.f, 0.f, 0.f}};
#pragma unroll 8
    for (int it = 0; it < 64; ++it) { const int k = it * 32 + F.wave * 4 + rsub;
        const f32x4 wv = MK_NTLD ? __builtin_nontemporal_load((const f32x4*)(W + (size_t)k * NMOD + n0 + 4 * cg)) : *(const f32x4*)(W + (size_t)k * NMOD + n0 + 4 * cg);
#pragma unroll
        for (int b = 0; b < 4; ++b) acc[b] = acc[b] + wv * sc[b * D + k]; }
#pragma unroll
    for (int b = 0; b < 4; ++b)
#pragma unroll
        for (int e = 0; e < 4; ++e) { float v = acc[b][e]; v += __shfl_xor(v, 16); v += __shfl_xor(v, 32); acc[b][e] = v; }
    if (rsub == 0) {
#pragma unroll
        for (int b = 0; b < 4; ++b) *(LAS f32x4*)(red + (F.wave * 4 + b) * 64 + 4 * cg) = acc[b]; }
    __syncthreads();
    if (F.tid < 256) { const int b = F.tid >> 6, c = F.tid & 63; float s = F.in[IN_BADA][n0 + c];
#pragma unroll
        for (int w = 0; w < 8; ++w) s += red[(w * 4 + b) * 64 + c];
        ((float*)(F.ws + WS_MOD))[(size_t)b * NMOD + n0 + c] = s; }
    asm volatile("s_waitcnt vmcnt(0)" ::: "memory");
    __syncthreads();
    if (F.tid == 0) {
        __builtin_amdgcn_fence(__ATOMIC_RELEASE, "agent"); asm volatile("s_waitcnt vmcnt(0)" ::: "memory");
        __hip_atomic_fetch_add(F.ctl + CW_GEMV, 1u, RLX_AGENT); }
}
__device__ __forceinline__ void gemv_wait(Frame& F) {
    if (F.tid == 0) { unsigned sp = 0;
        while (__hip_atomic_load(F.ctl + CW_GEMV, RLX_AGENT) < (unsigned)(NMOD / 64)) { __builtin_amdgcn_s_sleep(2); if (++sp > (1u << 22)) { __hip_atomic_store(F.ctl + CW_TMO, 0x6E3Fu, RLX_AGENT); break; } }
        __builtin_amdgcn_fence(__ATOMIC_ACQUIRE, "agent"); asm volatile("s_waitcnt vmcnt(0)" ::: "memory"); }
    __syncthreads();
}

__device__ __forceinline__ void p0_prologue(Frame& F) {
    constexpr int NGEMV = NMOD / 64;
    __syncthreads();
    if ((int)blockIdx.x < NGEMV) {
        LAS float* sc = (LAS float*)(F.lds + RING_OFF);
        for (int i = F.tid; i < BATCH * D; i += NWAVES * 64) { const float c = F.in[IN_C][i]; sc[i] = c / (1.0f + __expf(-c)); }
        __syncthreads();
        for (int r_ = 0; r_ < (MK_P0SUB == 1 ? 2 : 1); ++r_) for (int it = blockIdx.x; it < NGEMV; it += F.G) p0_gemv_item(F, it);
    }
    LAS float* scr = (LAS float*)(F.lds + RING_OFF + F.wave * 16640);
    const int gw = F.vcu * NWAVES + F.wave, NGW = F.G * NWAVES;
    if (!MK_SSMTAIL) for (int it = gw; it < NG * 33; it += NGW) p0_ssm_item<7>(F, it / 33, it % 33, scr);
    if (MK_P0SUB == 2) for (int it = gw; it < NG * 33; it += NGW) p0_ssm_item<MK_P0MODE>(F, it / 33, it % 33, scr);
    constexpr int I_IN = (D / 64) * (NIN / 64);
    bf16* WIN = (bf16*)(F.ws + WS_WIN);
    for (int r_ = 0; r_ < (MK_P0SUB == 3 ? 2 : 1); ++r_) for (int r = gw; r < I_IN; r += NGW) { const int nb = NIN / 64; p0_transpose_item(F.in[IN_WIN], NIN, WIN, D, scr, 64 * (r / nb), 64 * (r % nb), 64 * (r / nb), nullptr, F.lane); }
    { const int gt = gw * 64 + F.lane, NT = NGW * 64; float* rope = (float*)(F.ws + WS_ROPE); const int* pos = (const int*)F.in[IN_POS];
      for (int r_ = 0; r_ < (MK_P0SUB == 4 ? 2 : 1); ++r_) for (int it = gt; it < M * 8; it += NT) { const int row = it >> 3, j = it & 7;
          const float f = (float)exp(-(double)j * 0.125 * 13.122363377404328);
          const float ang = (float)pos[row] * f; double s, c; sincos_red((double)ang, s, c);
          rope[row * 16 + j] = (float)c; rope[row * 16 + 8 + j] = (float)s; } }
}

__device__ __forceinline__ void late_weight_items(Frame& F, int wi, int nw) {
    LAS float* scr = (LAS float*)(F.lds + RING_OFF + F.wave * 16640);
    constexpr int I_GLU = (NU / 64) * (NU / 64), I_OUT = (KOUT / 64) * (D / 64), I_ZP = 128;
    bf16* WGLU = (bf16*)(F.ws + WS_WGLU); bf16* WOUT = (bf16*)(F.ws + WS_WOUT);
    for (int it = wi; it < I_GLU + I_OUT + I_ZP; it += nw) {
        int r = it;
        if (r < I_GLU) { const int nb = NU / 64; p0_transpose_item(F.in[IN_WGLU], NU, WGLU, NU, scr, 64 * (r / nb), 64 * (r % nb), 64 * (r / nb), nullptr, F.lane); continue; } r -= I_GLU;
        if (r < I_OUT) { const int nb = D / 64; const int k0 = 64 * (r / nb);
            p0_transpose_item(F.in[IN_WOUT], D, WOUT, KOUT, scr, k0, 64 * (r % nb), k0 < NKV ? k0 + NU : k0 - NKV, k0 < NKV ? nullptr : F.in[IN_GSSM] + (k0 - NKV), F.lane); continue; } r -= I_OUT;
        { v4u* z = (v4u*)(WGLU + (size_t)(NU + r) * NU); for (int i = F.lane; i < NU * 2 / 16; i += 64) z[i] = (v4u){0u, 0u, 0u, 0u}; }
    }
}
__device__ __forceinline__ void mlp_weight_items(Frame& F, int wi, int nw, int lo_, int hi_) {
    LAS float* scr = (LAS float*)(F.lds + RING_OFF + F.wave * 16640);
    constexpr int I_1 = (D / 64) * (FF / 64);
    bf16* W1 = (bf16*)(F.ws + WS_W1); bf16* W2 = (bf16*)(F.ws + WS_W2);
    for (int it = lo_ + wi; it < hi_; it += nw) {
        if (it < I_1) { const int nb = FF / 64; p0_transpose_item(F.in[IN_W1], FF, W1, D, scr, 64 * (it / nb), 64 * (it % nb), 64 * (it / nb), nullptr, F.lane); }
        else { const int r = it - I_1, nb = D / 64; p0_transpose_item(F.in[IN_W2], D, W2, FF, scr, 64 * (r / nb), 64 * (r % nb), 64 * (r / nb), nullptr, F.lane); }
    }
}

struct Args { const float* in[25]; float* out; unsigned char* ws; int ph_lo, ph_hi, li, pad; };
__global__ void __launch_bounds__(NWAVES * 64, 2) mk_fwd(Args args) {
    extern __shared__ __attribute__((aligned(16))) unsigned char lds[];
    Frame F;
    F.lds = (LAS unsigned char*)lds;
    F.MISC = (volatile LAS unsigned*)(F.lds + MISC_OFF);
    F.tid = threadIdx.x; F.lane = F.tid & 63; F.wave = __builtin_amdgcn_readfirstlane(F.tid >> 6);
    F.G = gridDim.x; { const int bx = blockIdx.x; F.vcu = (F.G % 8 == 0) ? (bx % 8) * (F.G / 8) + bx / 8 : bx; }
    unsigned char* ws = args.ws; F.ws = ws; F.out = args.out;
    F.in = (KARGP)__builtin_amdgcn_kernarg_segment_ptr();
#define RELOAD_IN() asm volatile("" : "+s"(F.in))
    F.ctl = (gu32*)(ws + WS_CTL);
    for (int u = F.tid; u < (LDS_BYTES - LDSCTL_OFF) / 4; u += NWAVES * 64) ((LAS unsigned*)(F.lds + LDSCTL_OFF))[u] = 0u;
    __syncthreads();
    XcdBarrier bar; bar.bar = (unsigned*)(F.ctl + CW_BAR); bar.x = 0; bar.st = nullptr;
    if (!MK_PER_PHASE) bar = xcd_barrier_post((unsigned*)(F.ctl + CW_BAR), F.MISC + 8);
    if (!MK_PER_PHASE && MK_LOCALBAR && F.tid == 0) __hip_atomic_store(F.ctl + CW_XTAB + blockIdx.x, bar.x + 1u, RLX_AGENT);
#define SEAM_BAR() do { if (MK_PER_PHASE) { if (F.tid == 0) __hip_atomic_store(F.ctl + CW_TMO, 0xBADBA0u, RLX_AGENT); } else if (MK_LOCALBAR && F.MISC[12] != 0u) { xcc_local_barrier(bar, (unsigned*)F.ctl); } else { xcd_barrier(bar); } } while (0)
#define GRID_BAR() do { if (MK_PER_PHASE) { if (F.tid == 0) __hip_atomic_store(F.ctl + CW_TMO, 0xBADBA0u, RLX_AGENT); } else { xcd_barrier(bar); } } while (0)
    const int lo = args.ph_lo, hi = args.ph_hi;
#ifndef MK_PHASE_MASK
#define MK_PHASE_MASK 0xFFF
#endif
#define IN(k) (((MK_PHASE_MASK >> (k)) & 1) && lo <= (k) && (k) < hi)
#define BOTH(k) (IN(k) && IN((k) + 1))
    const int gw = F.vcu * NWAVES + F.wave, NGW = F.G * NWAVES;

    if (IN(0)) { RELOAD_IN(); for (int rep_ = 0; rep_ < ((MK_DUP == 0) ? 2 : 1); ++rep_) { p0_prologue(F); }
        if (!MK_PER_PHASE) { gemv_wait(F);
            if (MK_P1BAL && F.G == 256) {
                for (int m = gw; m < 7 * NGW; m += NGW) p1_row(F, m);
                if ((int)blockIdx.x >= NMOD / 64) { const int fw = ((int)blockIdx.x - NMOD / 64) * NWAVES + F.wave; for (int m = 7 * NGW + fw; m < M; m += (F.G - NMOD / 64) * NWAVES) p1_row(F, m); } }
            else for (int m = gw; m < M; m += NGW) p1_row(F, m); }
        if (BOTH(0)) { GRID_BAR();
            if (!MK_PER_PHASE && MK_LOCALBAR) {
                int ok = (F.G == 256) ? 1 : 0;
                if (ok && F.tid < 256) { const unsigned a = xb_ld((unsigned*)(F.ctl + CW_XTAB + F.tid)), r = xb_ld((unsigned*)(F.ctl + CW_XTAB + (F.tid & 7))); ok = (a != 0u && a == r) ? 1 : 0; }
                ok = __syncthreads_and(ok);
                if (F.tid == 0) F.MISC[12] = ok ? 1u : 0u;
                __syncthreads(); } } }
    if (IN(1) && MK_PER_PHASE) { RELOAD_IN(); for (int m = gw; m < M; m += NGW) p1_row(F, m); }
    if (IN(2)) { RELOAD_IN(); for (int rep_ = 0; rep_ < ((MK_DUP == 2) ? 2 : 1); ++rep_) {
        pg8::Gemm g{(const pg8::bf16_t*)(ws + WS_H), (const pg8::bf16_t*)(ws + WS_WIN), M, NIN, D}; pg8::StaticOrder S; S.init(M, NIN, F.G, (int)blockIdx.x); S.wgm = MK_WGM2;
        pg8::EpiProj E{(pg8::bf16_t*)(ws + WS_PROJ), (const float*)(ws + WS_ROPE), QSCALE, (pg8::bf16_t*)(ws + WS_UT)};
        pg8::gemm_phase<pg8::EpiProj, pg8::StaticOrder, PG8_ALIGN, PG8_SP2>(F.lds + RING_OFF, g, S, E);
        { constexpr int NWG = (M / 256) * (NIN / 256); const int nidle = F.G - NWG % F.G;
          if (NWG % F.G != 0 && (int)blockIdx.x >= NWG % F.G) { const int wi_ = ((int)blockIdx.x - NWG % F.G) * NWAVES + F.wave, nw_ = nidle * NWAVES;
              if (MK_SSMTAIL) { LAS float* scr_ = (LAS float*)(F.lds + RING_OFF + F.wave * 16640); for (int it = wi_; it < NG * 33; it += nw_) p0_ssm_item<7>(F, it / 33, it % 33, scr_); }
              mlp_weight_items(F, wi_, nw_, 0, MK_W1TAIL); }
          else if (NWG % F.G == 0) { if (MK_SSMTAIL) { LAS float* scr_ = (LAS float*)(F.lds + RING_OFF + F.wave * 16640); for (int it = gw; it < NG * 33; it += NGW) p0_ssm_item<7>(F, it / 33, it % 33, scr_); } mlp_weight_items(F, gw, NGW, 0, 4096); } }
        } if (BOTH(2)) GRID_BAR();
    }
    if (IN(3)) { RELOAD_IN(); for (int rep_ = 0; rep_ < ((MK_DUP == 3) ? 2 : 1); ++rep_) {
        for (int un = F.vcu; un < NG * BATCH; un += F.G) ssm_fused_block(F, un);
        attn_phase<15>(F); if (MK_SUB == 32) attn_phase<MK_AMODE>(F);
        late_weight_items(F, gw, NGW); mlp_weight_items(F, gw, NGW, MK_W1TAIL, 8192);
        } if (IN(3) && IN(6)) GRID_BAR();
    }
    if (IN(6)) { RELOAD_IN(); for (int rep_ = 0; rep_ < ((MK_DUP == 6) ? 2 : 1); ++rep_) {
        if (F.G == 256) { for (int k_ = 0; k_ < 4; ++k_) att_combine_rows(F, 2048 * (F.vcu >> 5) + 512 * k_ + 2 * (gw & 255)); }
        else for (int m = 2 * gw; m < M; m += 2 * NGW) att_combine_rows(F, m);
        pg8::Gemm g{(const pg8::bf16_t*)(ws + WS_YBUF), (const pg8::bf16_t*)(ws + WS_WGLU), M, NGLU_PAD, NU}; pg8::StaticOrder S; S.init(M, NGLU_PAD, F.G, (int)blockIdx.x);
        pg8::EpiGlu E{(pg8::bf16_t*)(ws + WS_AOUT), (const pg8::bf16_t*)(ws + WS_YBUF), F.in[IN_BGLU], (float*)(ws + WS_PGLU)};
        pg8::gemm_phase<pg8::EpiGlu, pg8::StaticOrder, PG8_ALIGN, PG8_SP2>(F.lds + RING_OFF, g, S, E);
        } if (BOTH(6)) SEAM_BAR();
    }
    if (IN(7)) { RELOAD_IN(); for (int rep_ = 0; rep_ < ((MK_DUP == 7) ? 2 : 1); ++rep_) {
        pg8::Gemm g{(const pg8::bf16_t*)(ws + WS_AOUT), (const pg8::bf16_t*)(ws + WS_WOUT), M, D, KOUT}; pg8::StaticOrder S; S.init(M, D, F.G, (int)blockIdx.x); S.wgm = MK_WGM7;
        typedef pg8::EpiGen<0, true, 14> Ep; Ep E{(pg8::bf16_t*)(ws + WS_MIX), D, (float*)(ws + WS_POUT), 32, (const float*)(ws + WS_PGLU), 1.0f / NU, EPS};
        pg8::gemm_phase<Ep, pg8::StaticOrder, PG8_ALIGN, PG8_SP2>(F.lds + RING_OFF, g, S, E);
        } if (BOTH(7)) SEAM_BAR();
    }
    if (IN(8)) { RELOAD_IN(); for (int rep_ = 0; rep_ < ((MK_DUP == 8) ? 2 : 1); ++rep_) { for (int bc = F.vcu; bc < M / 64; bc += F.G) p8_block(F, bc); } if (BOTH(8)) GRID_BAR(); }
    if (MK_SUB == 99 && !MK_PER_PHASE) { for (int i_ = 0; i_ < 10; ++i_) GRID_BAR(); }
    if (IN(9)) { RELOAD_IN(); for (int rep_ = 0; rep_ < ((MK_DUP == 9) ? 2 : 1); ++rep_) {
        pg8::Gemm g{(const pg8::bf16_t*)(ws + WS_H), (const pg8::bf16_t*)(ws + WS_W1), M, FF, D}; pg8::StaticOrder S; S.init(M, FF, F.G, (int)blockIdx.x); S.wgm = MK_WGM9;
        typedef pg8::EpiGen<2, false, 0, MK_NT9> Ep; Ep E{(pg8::bf16_t*)(ws + WS_HID), FF, nullptr, 0, nullptr, 0.f, 0.f};
        if (MK_SUB == 91) { for (int r_ = 0; r_ < 8; ++r_) { S.r0 = r_; S.nr = 1; pg8::gemm_phase<Ep, pg8::StaticOrder, PG8_ALIGN, PG8_SP2>(F.lds + RING_OFF, g, S, E); if (r_ < 7) GRID_BAR(); } }
        else pg8::gemm_phase<Ep, pg8::StaticOrder, PG8_ALIGN, PG8_SP2>(F.lds + RING_OFF, g, S, E);
        if (MK_GPROBE > 0) pg8::gemm_phase<Ep, pg8::StaticOrder, PG8_ALIGN, PG8_SP2, MK_GPROBE>(F.lds + RING_OFF, g, S, E);
        } if (BOTH(9)) SEAM_BAR();
    }
    if (IN(10)) { RELOAD_IN(); for (int rep_ = 0; rep_ < ((MK_DUP == 10) ? 2 : 1); ++rep_) {
        pg8::Gemm g{(const pg8::bf16_t*)(ws + WS_HID), (const pg8::bf16_t*)(ws + WS_W2), M, D, FF}; pg8::StaticOrder S; S.init(M, D, F.G, (int)blockIdx.x); S.wgm = MK_WGM10; S.rev = MK_REV10;
        typedef pg8::EpiGen<0, true, 0> Ep; Ep E{(pg8::bf16_t*)(ws + WS_H), D, (float*)(ws + WS_PY2), 32, nullptr, 0.f, 0.f};
        pg8::gemm_phase<Ep, pg8::StaticOrder, PG8_ALIGN, PG8_SP2, 0, MK_AUX10>(F.lds + RING_OFF, g, S, E);
        } if (BOTH(10)) SEAM_BAR();
    }
    if (IN(11)) { RELOAD_IN(); for (int rep_ = 0; rep_ < ((MK_DUP == 11) ? 2 : 1); ++rep_) { for (int bc = F.vcu; bc < M / 64; bc += F.G) p11_block(F, bc); } }
#undef IN
#undef BOTH
}

extern "C" void kernel_launch(void* const* d_in, const int* in_sizes, int n_in, void* d_out, int out_size, void* d_ws, size_t ws_size, hipStream_t stream) {
    static int grid = 0;
    if (grid == 0) {
        if (n_in != 25 || in_sizes[0] != M * D || out_size != M * D || ws_size < WS_END) { fprintf(stderr, "kernel_launch: unexpected shapes: n_in %d in0 %d out %d ws %zu (need %zu)\n", n_in, n_in > 0 ? in_sizes[0] : -1, out_size, ws_size, (size_t)WS_END); grid = -1; return; }
        int dev = 0, cus = 0, per_cu = 0;
        if (hipGetDevice(&dev) != hipSuccess || hipDeviceGetAttribute(&cus, hipDeviceAttributeMultiprocessorCount, dev) != hipSuccess) { fprintf(stderr, "kernel_launch: device query failed\n"); grid = -1; return; }
        if (hipFuncSetAttribute((const void*)mk_fwd, hipFuncAttributeMaxDynamicSharedMemorySize, LDS_BYTES) != hipSuccess) { fprintf(stderr, "kernel_launch: hipFuncSetAttribute failed\n"); grid = -1; return; }
        if (hipOccupancyMaxActiveBlocksPerMultiprocessor(&per_cu, (const void*)mk_fwd, NWAVES * 64, LDS_BYTES) != hipSuccess || per_cu < 1) { fprintf(stderr, "kernel_launch: occupancy query reports %d blocks per CU\n", per_cu); }
        (void)hipGetLastError();
        grid = cus;
    }
    if (grid < 0) return;
    if (hipMemsetAsync((char*)d_ws + WS_CTL, 0, CTL_ZERO_BYTES, stream) != hipSuccess) { fprintf(stderr, "kernel_launch: memset failed\n"); return; }
    Args a{};
    for (int i = 0; i < 25; ++i) a.in[i] = (const float*)d_in[i];
    a.out = (float*)d_out; a.ws = (unsigned char*)d_ws;
#if MK_PER_PHASE
    for (int p = 0; p < N_PHASES; ++p) { a.ph_lo = p; a.ph_hi = p + 1; a.li = p; hipLaunchKernelGGL(mk_fwd, dim3(grid), dim3(NWAVES * 64), LDS_BYTES, stream, a); }
#else
    a.ph_lo = 0; a.ph_hi = N_PHASES; a.li = 0;
    hipLaunchKernelGGL(mk_fwd, dim3(grid), dim3(NWAVES * 64), LDS_BYTES, stream, a);
#endif
    const hipError_t le = hipPeekAtLastError();
    if (le != hipSuccess) fprintf(stderr, "kernel_launch: launch failed: %s\n", hipGetErrorName(le));
}
```

```cpp
#include <hip/hip_runtime.h>
#include <cstdio>
#include <cstdint>
#include <cmath>
#ifndef MK_SEAM
#define MK_SEAM 1
#endif
#ifndef MK_PRIO
#define MK_PRIO 1
#endif
#ifndef MK_STATICPRIO
#define MK_STATICPRIO 0
#endif
namespace pg8 {
#define PG8_LAS __attribute__((address_space(3)))
typedef unsigned short bf16_t;
typedef short bf16x8 __attribute__((ext_vector_type(8)));
typedef float f32x4 __attribute__((ext_vector_type(4)));
typedef unsigned u32x4 __attribute__((ext_vector_type(4)));
constexpr int BM = 256, BK = 64, HALF = 128, HTB = HALF * BK * 2  , STAGE_BYTES = 8 * HTB, NXCD = 8, WGM = 8;

__host__ __device__ __forceinline__ int lds_byte(int r, int c) { const int st = (r >> 4) * 2 + (c >> 5), rr = r & 15, cc = c & 31, ob = rr * 64 + cc * 2; return st * 1024 + (ob ^ (((ob >> 9) & 1) << 5)); }
__host__ __device__ __forceinline__ void stage_rc(int b, int& R, int& C) { const int st = b / 1024, sb = b % 1024, swz = sb ^ (((sb >> 9) & 1) << 5); R = (st >> 1) * 16 + swz / 64; C = (st & 1) * 32 + (swz % 64) / 2; }
__host__ __device__ __forceinline__ int perm32(int rho) { const int n = rho >> 4, i = rho & 15; return 8 * (i >> 2) + 4 * n + (i & 3); }

struct Unit { int pm, pn; };
struct Gemm { const bf16_t* A; const bf16_t* Bt; int M, N, K; };

struct StaticOrder {
    int nM, nN, nwg, G, c, r0 = 0, nr = 1 << 30, wgm = WGM, rev = 0;
    __host__ __device__ void init(int M, int N, int G_, int c_) { nM = M / BM; nN = N / BM; nwg = nM * nN; G = G_; c = c_; }
    __host__ __device__ bool next(int i, Unit& u) const {
        if (i >= nr) return false;
        const int nrounds = (nwg + G - 1) / G; const int ii = rev ? nrounds - 1 - (i + r0) : i + r0; if (ii < 0) return false;
        const long L = (long)ii * G + c; if (L >= nwg) return false;
        int wgid = (int)L; { const int q = nwg / NXCD, r = nwg % NXCD, xcd = wgid % NXCD, off = wgid / NXCD; wgid = (xcd < r ? xcd * (q + 1) : r * (q + 1) + (xcd - r) * q) + off; }
        const int nig = wgm * nN, gid = wgid / nig, fm = gid * wgm, gsz = (nM - fm) < wgm ? (nM - fm) : wgm;
        u.pm = fm + ((wgid % nig) % gsz); u.pn = (wgid % nig) / gsz; return true;
    }
    __device__ __forceinline__ void a_ready(const Unit&) const {}
    __device__ __forceinline__ void done(const Unit&) const {}
};

__device__ __forceinline__ unsigned cvt_pk_bf16(float lo, float hi) { unsigned r; asm volatile("v_cvt_pk_bf16_f32 %0, %1, %2" : "=v"(r) : "v"(lo), "v"(hi)); return r; }
__device__ __forceinline__ float bf_lo(unsigned w) { return __uint_as_float(w << 16); }
__device__ __forceinline__ float bf_hi(unsigned w) { return __uint_as_float(w & 0xffff0000u); }

typedef float f32x2 __attribute__((ext_vector_type(2)));
__device__ __forceinline__ float relu_nc(float x) { float r; asm("v_max_f32_e32 %0, 0, %1" : "=v"(r) : "v"(x)); return r; }
template <int ACT  , bool STATS, int MID, int NT = 0  > struct EpiGen {
    static constexpr bool PERM = true, AFTER_DRAIN = false; static constexpr int MID_T = MID;
    bf16_t* O; int ldc; float* stats; int nstat; const float* midpart; float mid_inv_n, eps;
    __device__ __forceinline__ void mid(f32x4 (&acc)[2][2][4][2], const Unit& u, int wr, int wc, int fr, int fq) const {
        int row0 = u.pm * BM + wr * 64 + fr; asm volatile("" : "+v"(row0));
        const float* mp = midpart + (size_t)row0 * 16 + 4 * fq;
#pragma unroll
        for (int ai = 0; ai < 2; ++ai)
#pragma unroll
            for (int m = 0; m < 4; ++m) { const f32x4 a = *(const f32x4*)(mp + (ai * HALF + m * 16) * 16);
                float ss = (a[0] + a[1]) + (a[2] + a[3]); ss += __shfl_xor(ss, 16); ss += __shfl_xor(ss, 32);
                const float rs = 1.0f / sqrtf(ss * mid_inv_n + eps);
                asm volatile("" ::: "memory");
#pragma unroll
                for (int bj = 0; bj < 2; ++bj)
#pragma unroll
                    for (int n = 0; n < 2; ++n) acc[ai][bj][m][n] = acc[ai][bj][m][n] * rs; }
    }
    __device__ __forceinline__ void operator()(const f32x4 (&acc)[2][2][4][2], const Unit& u, int wr, int wc, int fr, int fq) const {
        const int row0 = u.pm * BM + wr * 64 + fr; const int col0 = u.pn * BM + wc * 32 + 8 * fq;
#pragma unroll
        for (int ai = 0; ai < 2; ++ai)
#pragma unroll
            for (int m = 0; m < 4; ++m) { const int row = row0 + ai * HALF + m * 16; bf16_t* rowp = O + (size_t)row * ldc + col0; float ss = 0.f;
#pragma unroll
                for (int bj = 0; bj < 2; ++bj) { f32x4 v0 = acc[ai][bj][m][0], v1 = acc[ai][bj][m][1];
                    if (ACT == 2) {
#pragma unroll
                        for (int i = 0; i < 4; i += 2) { f32x2 a = { relu_nc(v0[i]), relu_nc(v0[i + 1]) }, b = { relu_nc(v1[i]), relu_nc(v1[i + 1]) }; a = a * a; b = b * b;
                            v0[i] = a.x; v0[i + 1] = a.y; v1[i] = b.x; v1[i + 1] = b.y; } }
                    if (STATS) ss += ((v0[0] * v0[0] + v0[1] * v0[1]) + (v0[2] * v0[2] + v0[3] * v0[3])) + ((v1[0] * v1[0] + v1[1] * v1[1]) + (v1[2] * v1[2] + v1[3] * v1[3]));
                    u32x4 w; w.x = cvt_pk_bf16(v0[0], v0[1]); w.y = cvt_pk_bf16(v0[2], v0[3]); w.z = cvt_pk_bf16(v1[0], v1[1]); w.w = cvt_pk_bf16(v1[2], v1[3]);
                    if (NT == 1) __builtin_nontemporal_store(w, (u32x4*)(rowp + bj * HALF));
                    else if (NT == 2) { const bf16_t* sp = rowp + bj * HALF; asm volatile("global_store_dwordx4 %0, %1, off sc1\n\ts_nop 1" :: "v"(sp), "v"(w) : "memory"); }
                    else *(u32x4*)(rowp + bj * HALF) = w; }
                if (STATS) { ss += __shfl_xor(ss, 16); ss += __shfl_xor(ss, 32); if (fq == 0) stats[(size_t)row * nstat + u.pn * 4 + wc] = ss; } }
    }
};

struct EpiProj {
    static constexpr bool PERM = true, AFTER_DRAIN = false; static constexpr int MID_T = 0;
    bf16_t* O; const float* rope; float qscale; bf16_t* UT;
    __device__ __forceinline__ void mid(f32x4 (&)[2][2][4][2], const Unit&, int, int, int, int) const {}
    template <int K0, int K1> __device__ __forceinline__ void body(const f32x4 (&acc)[2][2][4][2], const Unit& u, int wr, int wc, int fr, int fq) const {
        const int row0 = u.pm * BM + wr * 64 + fr; const int col0 = u.pn * BM + wc * 32 + 8 * fq;
        constexpr bool anyrope = (K0 < 2) || (K1 < 2);
        const bool ropelane = (fq < 2) && ((wc & 1) == 0);
        const float sg = (fq == 0) ? -1.0f : 1.0f;
#pragma unroll
        for (int am = 0; am < 4; ++am) { const int ai = am >> 1;
            f32x4 rc[4][4];
            if constexpr (anyrope) {
#pragma unroll
                for (int m = 2 * (am & 1); m < 2 * (am & 1) + 2; ++m) { const f32x4* rp = (const f32x4*)(rope + (size_t)(row0 + ai * HALF + m * 16) * 16); rc[m][0] = rp[0]; rc[m][1] = rp[1]; rc[m][2] = rp[2]; rc[m][3] = rp[3]; } }
#pragma unroll
            for (int m = 2 * (am & 1); m < 2 * (am & 1) + 2; ++m) { const int row = row0 + ai * HALF + m * 16; bf16_t* rowp = O + (size_t)row * 2816 + col0;
#pragma unroll
                for (int bj = 0; bj < 2; ++bj) { constexpr int dummy = 0; (void)dummy; const int kind = bj == 0 ? K0 : K1;
                    f32x4 v0 = acc[ai][bj][m][0], v1 = acc[ai][bj][m][1];
                    if (kind < 2) {
                        f32x4 o0, o1;
#pragma unroll
                        for (int i = 0; i < 4; ++i) {
                            const auto ra = __builtin_amdgcn_permlane16_swap(__float_as_uint(v0[i]), __float_as_uint(v0[i]), false, false);
                            const auto rb = __builtin_amdgcn_permlane16_swap(__float_as_uint(v1[i]), __float_as_uint(v1[i]), false, false);
                            o0[i] = __uint_as_float((fq & 1) ? ra[0] : ra[1]); o1[i] = __uint_as_float((fq & 1) ? rb[0] : rb[1]); }
                        const f32x4 r0 = v0 * rc[m][0] + (o0 * rc[m][2]) * sg, r1 = v1 * rc[m][1] + (o1 * rc[m][3]) * sg;
#pragma unroll
                        for (int i = 0; i < 4; ++i) { v0[i] = ropelane ? r0[i] : v0[i]; v1[i] = ropelane ? r1[i] : v1[i]; }
                        if (kind == 0) { v0 = v0 * qscale; v1 = v1 * qscale; }
                    }
                    u32x4 w; w.x = cvt_pk_bf16(v0[0], v0[1]); w.y = cvt_pk_bf16(v0[2], v0[3]); w.z = cvt_pk_bf16(v1[0], v1[1]); w.w = cvt_pk_bf16(v1[2], v1[3]);
                    if (kind < 3) *(u32x4*)(rowp + bj * HALF) = w;
                    else { const int cu = col0 + bj * HALF - 1920; *(u32x4*)(UT + ((size_t)(cu >> 4) * 16384 + row) * 16 + (cu & 15)) = w; } } } }
    }
    __device__ __forceinline__ void operator()(const f32x4 (&acc)[2][2][4][2], const Unit& u, int wr, int wc, int fr, int fq) const {
        if (u.pn < 4) body<0, 0>(acc, u, wr, wc, fr, fq); else if (u.pn == 4) body<0, 1>(acc, u, wr, wc, fr, fq); else if (u.pn == 5) body<1, 1>(acc, u, wr, wc, fr, fq);
        else if (u.pn == 6) body<2, 2>(acc, u, wr, wc, fr, fq); else if (u.pn == 7) body<2, 3>(acc, u, wr, wc, fr, fq); else body<3, 3>(acc, u, wr, wc, fr, fq);
    }
};

struct EpiGlu {
    static constexpr bool PERM = true, AFTER_DRAIN = false; static constexpr int MID_T = 0;
    bf16_t* O; const bf16_t* Y; const float* bias; float* stats;
    __device__ __forceinline__ void mid(f32x4 (&)[2][2][4][2], const Unit&, int, int, int, int) const {}
    template <int NBJ> __device__ __forceinline__ void body(const f32x4 (&acc)[2][2][4][2], const Unit& u, int wr, int wc, int fr, int fq) const {
        const int row0 = u.pm * BM + wr * 64 + fr; const int col0 = u.pn * BM + wc * 32 + 8 * fq;
        f32x4 bv[NBJ][2]; u32x4 yv[2][4][NBJ];
#pragma unroll
        for (int bj = 0; bj < NBJ; ++bj)
#pragma unroll
            for (int n = 0; n < 2; ++n) bv[bj][n] = *(const f32x4*)(bias + col0 + bj * HALF + 4 * n);
#pragma unroll
        for (int ai = 0; ai < 2; ++ai)
#pragma unroll
            for (int m = 0; m < 4; ++m)
#pragma unroll
                for (int bj = 0; bj < NBJ; ++bj) yv[ai][m][bj] = *(const u32x4*)(Y + (size_t)(row0 + ai * HALF + m * 16) * 896 + col0 + bj * HALF);
#pragma unroll
        for (int ai = 0; ai < 2; ++ai)
#pragma unroll
            for (int m = 0; m < 4; ++m) { const int row = row0 + ai * HALF + m * 16; float ss = 0.f;
#pragma unroll
                for (int bj = 0; bj < NBJ; ++bj) { const int col = col0 + bj * HALF;
                    const f32x4 z0 = acc[ai][bj][m][0] + bv[bj][0], z1 = acc[ai][bj][m][1] + bv[bj][1];
                    const u32x4 yw = yv[ai][m][bj];
                    float y[8] = {bf_lo(yw.x), bf_hi(yw.x), bf_lo(yw.y), bf_hi(yw.y), bf_lo(yw.z), bf_hi(yw.z), bf_lo(yw.w), bf_hi(yw.w)};
                    float s[8];
#pragma unroll
                    for (int i = 0; i < 4; ++i) { s[i] = y[i] * __builtin_amdgcn_rcpf(1.0f + __builtin_amdgcn_exp2f(-1.4426950408889634f * z0[i])); s[4 + i] = y[4 + i] * __builtin_amdgcn_rcpf(1.0f + __builtin_amdgcn_exp2f(-1.4426950408889634f * z1[i])); }
#pragma unroll
                    for (int i = 0; i < 8; ++i) ss += s[i] * s[i];
                    u32x4 w; w.x = cvt_pk_bf16(s[0], s[1]); w.y = cvt_pk_bf16(s[2], s[3]); w.z = cvt_pk_bf16(s[4], s[5]); w.w = cvt_pk_bf16(s[6], s[7]);
                    *(u32x4*)(O + (size_t)row * 1280 + col) = w; }
                ss += __shfl_xor(ss, 16); ss += __shfl_xor(ss, 32); if (fq == 0) stats[(size_t)row * 16 + u.pn * 4 + wc] = ss; }
    }
    __device__ __forceinline__ void operator()(const f32x4 (&acc)[2][2][4][2], const Unit& u, int wr, int wc, int fr, int fq) const {
        if (u.pn < 3) body<2>(acc, u, wr, wc, fr, fq); else body<1>(acc, u, wr, wc, fr, fq);
    }
};

template <class Epi, class Sched, bool ALIGN_EPI = false, bool SP2 = false, int PROBE = 0  , int AUXA = 0  >
__device__ __forceinline__ void gemm_phase(PG8_LAS unsigned char* lds, const Gemm g, const Sched& S, const Epi& E) {
    const int tid = threadIdx.x, wid = __builtin_amdgcn_readfirstlane(tid >> 6), lane = tid & 63, wr = wid >> 2, wc = wid & 3, fr = lane & 15, fq = lane >> 4;
    const int K = g.K, nt = K / BK;
    unsigned voffA[2], voffB[2];
#pragma unroll
    for (int i = 0; i < 2; ++i) { int R, C; stage_rc(tid * 16 + i * 8192, R, C); const int Rb = Epi::PERM ? ((R & ~31) + perm32(R & 31)) : R;
        voffA[i] = (unsigned)(R * K + C) * 2u; voffB[i] = (unsigned)(Rb * K + C) * 2u; }
    const size_t kstep = (size_t)(BK * 2);
    const size_t hstep = (size_t)HALF * K * 2;
    const size_t tstep = 2 * hstep;
    const unsigned ldsw = (unsigned)wid * 1024u;
    const int aoff = lds_byte(wr * 64 + fr, fq * 8), boff = lds_byte(wc * 32 + fr, fq * 8);
#define PG8_SA(b, h) (((b) * 2 + (h)) * HTB)
#define PG8_SB(b, h) ((4 + (b) * 2 + (h)) * HTB)
#define PG8_STAGE(bufoff, gbase, voff) do { if (!(PROBE & 2)) _Pragma("unroll") for (int _i = 0; _i < 2; ++_i) \
        __builtin_amdgcn_global_load_lds((const unsigned*)((const char*)(gbase) + (voff)[_i]), (PG8_LAS unsigned*)(lds + (bufoff) + ldsw + _i * 8192), 16, 0, 0); } while (0)
#define PG8_STAGEA(bufoff, gbase, voff) do { if (!(PROBE & 2)) _Pragma("unroll") for (int _i = 0; _i < 2; ++_i) \
        __builtin_amdgcn_global_load_lds((const unsigned*)((const char*)(gbase) + (voff)[_i]), (PG8_LAS unsigned*)(lds + (bufoff) + ldsw + _i * 8192), 16, 0, AUXA); } while (0)
#define PG8_LDA(dst, b, h) do { if (!(PROBE & 8)) _Pragma("unroll") for (int m = 0; m < 4; ++m) _Pragma("unroll") for (int k = 0; k < 2; ++k) dst[m][k] = *(const PG8_LAS bf16x8*)(lds + PG8_SA(b, h) + aoff + m * 2048 + k * 1024); } while (0)
#define PG8_LDB(dst, b, h) do { if (!(PROBE & 8)) _Pragma("unroll") for (int n = 0; n < 2; ++n) _Pragma("unroll") for (int k = 0; k < 2; ++k) dst[n][k] = *(const PG8_LAS bf16x8*)(lds + PG8_SB(b, h) + boff + n * 2048 + k * 1024); } while (0)
#define PG8_MMA(ai, bj, At, Bt) do { if (!MK_STATICPRIO) __builtin_amdgcn_s_setprio(MK_PRIO); if (!(PROBE & 1)) _Pragma("unroll") for (int m = 0; m < 4; ++m) _Pragma("unroll") for (int n = 0; n < 2; ++n) _Pragma("unroll") for (int k = 0; k < 2; ++k) \
        acc[ai][bj][m][n] = __builtin_amdgcn_mfma_f32_16x16x32_bf16(Bt[n][k], At[m][k], acc[ai][bj][m][n], 0, 0, 0); if (!MK_STATICPRIO) __builtin_amdgcn_s_setprio(0); } while (0)
#define PG8_WAIT_V(n) asm volatile("s_waitcnt vmcnt(" #n ")" ::: "memory")
#define PG8_WAIT_L(n) asm volatile("s_waitcnt lgkmcnt(" #n ")" ::: "memory")
#define PG8_BAR __builtin_amdgcn_s_barrier()
#define PG8_SCHED __builtin_amdgcn_sched_barrier(0)
    Unit cur, nxt; int ui = 0;
    if (!S.next(0, cur)) return;
    if (MK_STATICPRIO) { if (wid >= 4) __builtin_amdgcn_s_setprio(1); }
    f32x4 acc[2][2][4][2];
#pragma unroll
    for (int a = 0; a < 2; ++a)
#pragma unroll
        for (int b = 0; b < 2; ++b)
#pragma unroll
            for (int m = 0; m < 4; ++m)
#pragma unroll
                for (int n = 0; n < 2; ++n) acc[a][b][m][n] = (f32x4){0.f, 0.f, 0.f, 0.f};
    bf16x8 At[4][2], B0[2][2], B1[2][2];
    if constexpr ((PROBE & 8) != 0) {
#pragma unroll
        for (int m = 0; m < 4; ++m)
#pragma unroll
            for (int k = 0; k < 2; ++k) asm volatile("" : "=v"(At[m][k]));
#pragma unroll
        for (int n = 0; n < 2; ++n)
#pragma unroll
            for (int k = 0; k < 2; ++k) { asm volatile("" : "=v"(B0[n][k])); asm volatile("" : "=v"(B1[n][k])); } }
    const char* cA = (const char*)g.A + (size_t)((PROBE & 16) ? 0 : cur.pm) * tstep; const char* cB = (const char*)g.Bt + (size_t)((PROBE & 16) ? 0 : cur.pn) * tstep;
    S.a_ready(cur);
    if constexpr (SP2) {
        PG8_STAGE(PG8_SB(0, 0), cB, voffB); PG8_STAGE(PG8_SB(0, 1), cB + hstep, voffB); PG8_STAGEA(PG8_SA(0, 0), cA, voffA); PG8_STAGEA(PG8_SA(0, 1), cA + hstep, voffA);
        if (wr == 1) PG8_BAR;
        PG8_WAIT_V(2); PG8_BAR;
        PG8_STAGE(PG8_SB(1, 0), cB + kstep, voffB); PG8_STAGEA(PG8_SA(1, 0), cA + kstep, voffA); PG8_STAGE(PG8_SB(1, 1), cB + hstep + kstep, voffB);
        PG8_WAIT_V(6); PG8_BAR;
    } else {
        PG8_STAGE(PG8_SB(0, 0), cB, voffB); PG8_STAGEA(PG8_SA(0, 0), cA, voffA); PG8_STAGE(PG8_SB(0, 1), cB + hstep, voffB); PG8_STAGEA(PG8_SA(0, 1), cA + hstep, voffA);
        if (wr == 1) PG8_BAR;
        PG8_WAIT_V(4); PG8_BAR;
        PG8_STAGE(PG8_SB(1, 0), cB + kstep, voffB); PG8_STAGEA(PG8_SA(1, 0), cA + kstep, voffA); PG8_STAGE(PG8_SB(1, 1), cB + hstep + kstep, voffB);
        PG8_WAIT_V(6); PG8_BAR;
    }
    for (;;) {
        const bool has_next = S.next(ui + 1, nxt);
        const char* nA = (has_next && !(PROBE & 16)) ? (const char*)g.A + (size_t)nxt.pm * tstep : cA; const char* nB = (has_next && !(PROBE & 16)) ? (const char*)g.Bt + (size_t)nxt.pn * tstep : cB;
        for (int t = 0; t < nt; t += 2) {
            if constexpr (Epi::MID_T > 0) { if (t == Epi::MID_T) E.mid(acc, cur, wr, wc, fr, fq); }
            const bool last = (t == nt - 2);
            const char* a1 = cA + (size_t)(t + 1) * kstep;
            const char* a2 = last ? nA : cA + (size_t)(t + 2) * kstep; const char* b2 = last ? nB : cB + (size_t)(t + 2) * kstep;
            const char* a3 = a2 + kstep; const char* b3 = b2 + kstep;
            if (last && has_next) S.a_ready(nxt);
            if constexpr (SP2) {
            PG8_LDB(B0, 0, 0); PG8_LDB(B1, 0, 1); PG8_SCHED; PG8_LDA(At, 0, 0); PG8_STAGEA(PG8_SA(1, 1), a1 + hstep, voffA);
            PG8_WAIT_V(8); PG8_WAIT_L(0); PG8_BAR; PG8_MMA(0, 0, At, B0); PG8_MMA(0, 1, At, B1); PG8_BAR; PG8_SCHED;
            PG8_LDA(At, 0, 1); PG8_STAGE(PG8_SB(0, 0), b2, voffB); PG8_STAGE(PG8_SB(0, 1), b2 + hstep, voffB); PG8_STAGEA(PG8_SA(0, 0), a2, voffA);
            PG8_WAIT_V(8); PG8_WAIT_L(0); PG8_BAR; PG8_MMA(1, 0, At, B0); PG8_MMA(1, 1, At, B1); PG8_BAR; PG8_SCHED;
            PG8_LDB(B0, 1, 0); PG8_LDB(B1, 1, 1); PG8_SCHED; PG8_LDA(At, 1, 0); PG8_STAGEA(PG8_SA(0, 1), a2 + hstep, voffA);
            PG8_WAIT_V(8); PG8_WAIT_L(0); PG8_BAR; PG8_MMA(0, 0, At, B0); PG8_MMA(0, 1, At, B1); PG8_BAR; PG8_SCHED;
            PG8_LDA(At, 1, 1); PG8_STAGE(PG8_SB(1, 0), b3, voffB); PG8_STAGE(PG8_SB(1, 1), b3 + hstep, voffB); PG8_STAGEA(PG8_SA(1, 0), a3, voffA);
            PG8_WAIT_V(8); PG8_WAIT_L(0); PG8_BAR; PG8_MMA(1, 0, At, B0); PG8_MMA(1, 1, At, B1); PG8_BAR; PG8_SCHED;
            } else {
            PG8_LDB(B0, 0, 0); PG8_SCHED; PG8_LDA(At, 0, 0); PG8_STAGEA(PG8_SA(1, 1), a1 + hstep, voffA);
            PG8_WAIT_L(8); PG8_BAR; PG8_WAIT_L(0); PG8_MMA(0, 0, At, B0); PG8_BAR; PG8_SCHED;
            PG8_LDB(B1, 0, 1); PG8_STAGE(PG8_SB(0, 0), b2, voffB);
            PG8_BAR; PG8_WAIT_L(0); PG8_MMA(0, 1, At, B1); PG8_BAR;
            PG8_LDA(At, 0, 1); PG8_STAGEA(PG8_SA(0, 0), a2, voffA);
            PG8_BAR; PG8_WAIT_L(0); PG8_MMA(1, 0, At, B0); PG8_BAR; PG8_SCHED;
            PG8_STAGE(PG8_SB(0, 1), b2 + hstep, voffB);
            PG8_WAIT_V(6); PG8_BAR; PG8_MMA(1, 1, At, B1); PG8_BAR;
            PG8_LDB(B0, 1, 0); PG8_SCHED; PG8_LDA(At, 1, 0); PG8_STAGEA(PG8_SA(0, 1), a2 + hstep, voffA);
            PG8_WAIT_L(8); PG8_BAR; PG8_WAIT_L(0); PG8_MMA(0, 0, At, B0); PG8_BAR; PG8_SCHED;
            PG8_LDB(B1, 1, 1); PG8_STAGE(PG8_SB(1, 0), b3, voffB);
            PG8_BAR; PG8_WAIT_L(0); PG8_MMA(0, 1, At, B1); PG8_BAR;
            PG8_LDA(At, 1, 1); PG8_STAGEA(PG8_SA(1, 0), a3, voffA);
            PG8_BAR; PG8_WAIT_L(0); PG8_MMA(1, 0, At, B0); PG8_BAR; PG8_SCHED;
            PG8_STAGE(PG8_SB(1, 1), b3 + hstep, voffB);
            PG8_WAIT_V(6); PG8_BAR; PG8_MMA(1, 1, At, B1); PG8_BAR;
            }
        }
        if constexpr (ALIGN_EPI) { if (wr == 0) PG8_BAR; }
        if constexpr (!Epi::AFTER_DRAIN) { if constexpr (PROBE & 4) { _Pragma("unroll") for (int a_ = 0; a_ < 2; ++a_) _Pragma("unroll") for (int b_ = 0; b_ < 2; ++b_) _Pragma("unroll") for (int m_ = 0; m_ < 4; ++m_) _Pragma("unroll") for (int n_ = 0; n_ < 2; ++n_) asm volatile("" :: "v"(acc[a_][b_][m_][n_])); } else { E(acc, cur, wr, wc, fr, fq); } S.done(cur); }
        if (!has_next) break;
#pragma unroll
        for (int a = 0; a < 2; ++a)
#pragma unroll
            for (int b = 0; b < 2; ++b)
#pragma unroll
                for (int m = 0; m < 4; ++m)
#pragma unroll
                    for (int n = 0; n < 2; ++n) acc[a][b][m][n] = (f32x4){0.f, 0.f, 0.f, 0.f};
        cur = nxt; cA = nA; cB = nB; ++ui;
        if constexpr (ALIGN_EPI) { if (wr == 1) PG8_BAR; }
    }
    if (MK_STATICPRIO) __builtin_amdgcn_s_setprio(0);
    PG8_WAIT_V(0);
    if constexpr (!ALIGN_EPI) { if (wr == 0) PG8_BAR; }
    PG8_BAR;
    if constexpr (Epi::AFTER_DRAIN) { E.fused(acc, cur, wr, wc, fr, fq, lds, wid, lane); S.done(cur); }
#undef PG8_SA
#undef PG8_SB
#undef PG8_STAGE
#undef PG8_STAGEA
#undef PG8_LDA
#undef PG8_LDB
#undef PG8_MMA
#undef PG8_WAIT_V
#undef PG8_WAIT_L
#undef PG8_BAR
#undef PG8_SCHED
}
}

#ifndef PG8_SP2
#define PG8_SP2 true
#endif
#ifndef PG8_ALIGN
#define PG8_ALIGN true
#endif
#ifndef MK_PER_PHASE
#define MK_PER_PHASE 0
#endif

#ifndef MK_P0SUB
#define MK_P0SUB 0
#endif
#ifndef MK_P0MODE
#define MK_P0MODE 7
#endif
#ifndef MK_SUB
#define MK_SUB 0
#endif
#ifndef MK_CMODE
#define MK_CMODE 7
#endif
#ifndef MK_GPROBE
#define MK_GPROBE 0
#endif
#ifndef MK_NT9
#define MK_NT9 0
#endif
#ifndef MK_W1TAIL
#define MK_W1TAIL 4096
#endif
#ifndef MK_AMODE
#define MK_AMODE 15
#endif
#ifndef MK_P1G
#define MK_P1G 53
#endif
#ifndef MK_NTLD
#define MK_NTLD 3
#endif
#ifndef MK_AUX10
#define MK_AUX10 0
#endif
#ifndef MK_WGM10
#define MK_WGM10 4
#endif
#ifndef MK_WGM9
#define MK_WGM9 4
#endif
#ifndef MK_WGM7
#define MK_WGM7 4
#endif
#ifndef MK_WGM2
#define MK_WGM2 4
#endif
#ifndef MK_REV10
#define MK_REV10 1
#endif
#ifndef MK_P1BAL
#define MK_P1BAL 0
#endif
#ifndef MK_SSMTAIL
#define MK_SSMTAIL 0
#endif
#ifndef MK_LOCALBAR
#define MK_LOCALBAR 1
#endif
#ifndef MK_DUP
#define MK_DUP -1
#endif

constexpr int NWAVES = 8;
constexpr int BATCH = 4, SEQ = 4096, M = BATCH * SEQ, D = 2048;
constexpr int NQ = 1152, NKV = 384, NU = 896, NIN = 2816, COL_K = 1152, COL_V = 1536, COL_U = 1920;
constexpr int KOUT = 1280, FF = 8192, NMOD = 6 * D;
constexpr int NG = 56, NST = 64, NCH = 16, LC = 32, NCOL = M / LC;
constexpr int NGLU_PAD = 1024;
constexpr float EPS = 1e-6f;
constexpr float QSCALE = 0.125f * 1.4426950408889634f;
constexpr int N_PHASES = 12;

constexpr size_t MiB = 1u << 20;
constexpr size_t WS_CTL = 0, CTL_ZERO_BYTES = 32 * 1024;
constexpr size_t WS_MOD = 1 * MiB;
constexpr size_t WS_AL = 1 * MiB + 256 * 1024;
constexpr size_t WS_ROPE = 2 * MiB;
constexpr size_t WS_KT = 3 * MiB;
constexpr size_t WS_WET = 4 * MiB;
constexpr size_t WS_G = 11 * MiB;
constexpr size_t WS_WIN = 18 * MiB;
constexpr size_t WS_WGLU = 29 * MiB;
constexpr size_t WS_WOUT = 31 * MiB;
constexpr size_t WS_W1 = 36 * MiB;
constexpr size_t WS_W2 = 68 * MiB;
constexpr size_t WS_H = 448 * MiB;
constexpr size_t WS_MIX = 384 * MiB;
constexpr size_t WS_PGLU = 356 * MiB;
constexpr size_t WS_POUT = 357 * MiB;
constexpr size_t WS_PY2 = 359 * MiB;
constexpr size_t WS_LSE = 320 * MiB;
constexpr size_t WS_PROJ = 100 * MiB;
constexpr size_t WS_E = 362 * MiB;
constexpr size_t WS_CARRY = 362 * MiB;
constexpr size_t WS_OBUF = 216 * MiB;
constexpr size_t WS_YBUF = 252 * MiB;
constexpr size_t WS_AOUT = 280 * MiB;
constexpr size_t WS_UT = 188 * MiB;
constexpr size_t WS_HID = 100 * MiB;
constexpr size_t WS_END = 512 * MiB;
static_assert(WS_PROJ + (size_t)M * NIN * 2 <= WS_UT && WS_UT + (size_t)M * NU * 2 <= WS_OBUF && WS_OBUF + (size_t)3 * M * NKV * 2 <= WS_YBUF && WS_YBUF + (size_t)M * NU * 2 <= WS_AOUT && WS_AOUT + (size_t)M * KOUT * 2 <= WS_LSE &&
              WS_LSE + (size_t)3 * M * 8 * 4 <= WS_PGLU && WS_HID + (size_t)M * FF * 2 <= WS_PGLU && WS_PY2 + (size_t)M * 32 * 4 <= WS_MIX && WS_MIX + (size_t)M * D * 2 <= WS_H && WS_H + (size_t)M * D * 2 <= WS_END && WS_W2 + (size_t)D * FF * 2 <= WS_HID, "d_ws map");
constexpr int CW_TMO = 0, CW_CODE = 1, CW_GEMV = 64, CW_XTAB = 512  , CW_P7DONE = 832  , CW_BAR = 4096;
static_assert((CW_BAR + 3456) * 4 <= (int)CTL_ZERO_BYTES, "control words inside the memset region");

constexpr int LDS_BYTES_C = 147456;
constexpr int RING_OFF = 0, RING_BYTES = 131072;
constexpr int LDSCTL_OFF = 8 * 16640  , MISC_OFF = LDSCTL_OFF + 320;
static_assert(LDSCTL_OFF >= RING_BYTES && MISC_OFF + 128 <= LDS_BYTES_C, "LDS map");
constexpr int LDS_BYTES = 147456;

#define GAS __attribute__((address_space(1)))
#define LAS __attribute__((address_space(3)))
typedef unsigned short bf16;
typedef unsigned v4u __attribute__((ext_vector_type(4)));
typedef float f32x4 __attribute__((ext_vector_type(4)));
typedef short bf16x8 __attribute__((ext_vector_type(8)));
typedef GAS unsigned gu32;
typedef GAS unsigned long long gu64;
#define RLX_AGENT __ATOMIC_RELAXED, __HIP_MEMORY_SCOPE_AGENT
#define LDS_WAIT() asm volatile("s_waitcnt lgkmcnt(0)" ::: "memory")
#define VM_WAIT() asm volatile("s_waitcnt vmcnt(0)" ::: "memory")
__device__ __forceinline__ unsigned long long rt() { return __builtin_amdgcn_s_memrealtime(); }
__device__ __forceinline__ unsigned f2bf(float f) { unsigned u = __builtin_bit_cast(unsigned, f); return (u + 0x7fffu + ((u >> 16) & 1u)) >> 16; }
__device__ __forceinline__ unsigned pk2(float lo, float hi) { return f2bf(lo) | (f2bf(hi) << 16); }

#define XB_TMO      128
#define XB_XCNT(j)  (256  + 64 * (j))
#define XB_XSUB(j)  (1280 + 64 * (j))
#define XB_XGEN(j)  (2304 + 64 * (j))
#define XB_TOP      3328
#define XB_TOPGEN   3392
#define XCD_BAR_WORDS 3456
#define XB_SPIN_CAP (1u << 18)

__device__ __forceinline__ unsigned xb_ld(unsigned* p)              { return __hip_atomic_load(p, __ATOMIC_RELAXED, __HIP_MEMORY_SCOPE_AGENT); }
__device__ __forceinline__ unsigned xb_add(unsigned* p, unsigned v) { return __hip_atomic_fetch_add(p, v, __ATOMIC_RELAXED, __HIP_MEMORY_SCOPE_AGENT); }
__device__ __forceinline__ unsigned xb_xcc_id() { return (unsigned)__builtin_amdgcn_s_getreg((3 << 11) | 20) & 0xFu; }
#define XB_SPIN(cond, bar) do { unsigned _sp = 0; while (cond) { __builtin_amdgcn_s_sleep(1); \
    if ((++_sp & 255u) == 0u) { if (xb_ld(&(bar)[XB_TMO])) break; if (_sp > XB_SPIN_CAP) { atomicAdd(&(bar)[XB_TMO], 1u); break; } } } } while (0)

struct XcdBarrier {
    unsigned* bar; unsigned x;
    volatile LAS unsigned* st;
};

__device__ __forceinline__ XcdBarrier xcd_barrier_post(unsigned* bar, volatile LAS unsigned* st) {
    XcdBarrier b; b.bar = bar; b.x = xb_xcc_id(); b.st = st;
    if (threadIdx.x == 0) (void)xb_add(&bar[XB_XCNT(b.x)], 1u);
    return b;
}
__device__ __forceinline__ void xcd_barrier_complete(unsigned* bar, unsigned x, unsigned& nloc, unsigned& nx) {
    const unsigned G = gridDim.x * gridDim.y * gridDim.z;
    unsigned sum, cnt, mine, sp = 0u;
    for (;;) {
        sum = 0u; cnt = 0u; mine = 0u;
#pragma unroll
        for (unsigned j = 0; j < 16; ++j) { const unsigned c = xb_ld(&bar[XB_XCNT(j)]); sum += c; cnt += (c > 0u) ? 1u : 0u; mine = (j == x) ? c : mine; }
        if (sum == G) break;
        __builtin_amdgcn_s_sleep(1);
        if ((++sp & 255u) == 0u) { if (xb_ld(&bar[XB_TMO])) break; if (sp > XB_SPIN_CAP) { atomicAdd(&bar[XB_TMO], 1u); break; } }
    }
    nloc = mine > 0u ? mine : 1u; nx = cnt > 0u ? cnt : 1u;
}

__device__ __forceinline__ void xcd_barrier(const XcdBarrier& b) {
    asm volatile("s_waitcnt vmcnt(0)" ::: "memory");
    __syncthreads();
    if (threadIdx.x == 0) {
        unsigned* bar = b.bar;
        __builtin_amdgcn_s_waitcnt(0);
        unsigned nloc = b.st[0], nx = b.st[1];
        if (nloc == 0u) { xcd_barrier_complete(bar, b.x, nloc, nx); b.st[0] = nloc; b.st[1] = nx; }
        const unsigned old = xb_add(&bar[XB_XSUB(b.x)], 1u);
        const unsigned gen = old / nloc;
        if (old + 1u == (gen + 1u) * nloc) {
            __builtin_amdgcn_fence(__ATOMIC_RELEASE, "agent");
            asm volatile("s_waitcnt vmcnt(0)" ::: "memory");
            const unsigned og = xb_add(&bar[XB_TOP], 1u);
            const unsigned tg = og / nx;
            if (og + 1u == (tg + 1u) * nx) xb_add(&bar[XB_TOPGEN], 1u);
            else XB_SPIN(xb_ld(&bar[XB_TOPGEN]) == tg, bar);
            __builtin_amdgcn_fence(__ATOMIC_ACQUIRE, "agent");
            xb_add(&bar[XB_XGEN(b.x)], 1u);
            asm volatile("s_waitcnt vmcnt(0)" ::: "memory");
        } else {
            XB_SPIN(xb_ld(&bar[XB_XGEN(b.x)]) == gen, bar);
            __builtin_amdgcn_fence(__ATOMIC_ACQUIRE, "agent");
            asm volatile("s_waitcnt vmcnt(0)" ::: "memory");
        }
    }
    __syncthreads();
}

#define XL_SUB(j) (1024 + 64 * (j))
#define XL_GEN(j) (2048 + 64 * (j))
template <bool PUB, bool WAITW> __device__ __forceinline__ void xcc_local_barrier_x(const XcdBarrier& b, unsigned* ctl, unsigned* pub, unsigned* waitw) {
    asm volatile("s_waitcnt vmcnt(0)" ::: "memory");
    __syncthreads();
    if (threadIdx.x == 0) {
        __builtin_amdgcn_s_waitcnt(0);
        const unsigned nloc = b.st[0], nx = b.st[1];
        const unsigned old = xb_add(&ctl[XL_SUB(b.x)], 1u);
        const unsigned gen = old / nloc;
        if (old + 1u == (gen + 1u) * nloc) {
            if (PUB) xb_add(pub, 1u);
            if (WAITW) XB_SPIN(xb_ld(waitw) < nx, b.bar);
            xb_add(&ctl[XL_GEN(b.x)], 1u); }
        else XB_SPIN(xb_ld(&ctl[XL_GEN(b.x)]) == gen, b.bar);
        __builtin_amdgcn_fence(__ATOMIC_ACQUIRE, "agent");
        asm volatile("s_waitcnt vmcnt(0)" ::: "memory");
    }
    __syncthreads();
}
__device__ __forceinline__ void xcc_local_barrier(const XcdBarrier& b, unsigned* ctl) {
    asm volatile("s_waitcnt vmcnt(0)" ::: "memory");
    __syncthreads();
    if (threadIdx.x == 0) {
        __builtin_amdgcn_s_waitcnt(0);
        const unsigned nloc = b.st[0];
        const unsigned old = xb_add(&ctl[XL_SUB(b.x)], 1u);
        const unsigned gen = old / nloc;
        if (old + 1u == (gen + 1u) * nloc) xb_add(&ctl[XL_GEN(b.x)], 1u);
        else XB_SPIN(xb_ld(&ctl[XL_GEN(b.x)]) == gen, b.bar);
        __builtin_amdgcn_fence(__ATOMIC_ACQUIRE, "agent");
        asm volatile("s_waitcnt vmcnt(0)" ::: "memory");
    }
    __syncthreads();
}

typedef float f32x16 __attribute__((ext_vector_type(16)));
typedef unsigned u32x4 __attribute__((ext_vector_type(4)));
typedef short s16x4 __attribute__((ext_vector_type(4)));
typedef unsigned u32x2 __attribute__((ext_vector_type(2)));
typedef const float* const __attribute__((address_space(4)))* KARGP;
struct Frame {
    LAS unsigned char* lds;
    volatile LAS unsigned* MISC;
    gu32* ctl;
    int tid, lane, wave;
    int vcu, G;
    KARGP in; float* out; unsigned char* ws;
};
#define IN_X 0
#define IN_C 1
#define IN_POS 2
#define IN_WADA 3
#define IN_BADA 4
#define IN_GPREMIX 5
#define IN_GPOSTMIX 6
#define IN_WIN 7
#define IN_ARE 8
#define IN_AIM 9
#define IN_LOGDT 10
#define IN_BRE 11
#define IN_BIM 12
#define IN_CRE 13
#define IN_CIM 14
#define IN_SSMD 15
#define IN_WGLU 16
#define IN_BGLU 17
#define IN_GATT 18
#define IN_GSSM 19
#define IN_WOUT 20
#define IN_GPREMLP 21
#define IN_GPOSTMLP 22
#define IN_W1 23
#define IN_W2 24

__device__ __forceinline__ float wave_sum(float v) {
#pragma unroll
    for (int o = 1; o < 64; o <<= 1) v += __shfl_xor(v, o);
    return v;
}
__device__ __forceinline__ int crow(int r, int hi) { return (r & 3) + 8 * (r >> 2) + 4 * hi; }


__device__ __forceinline__ void sincos_red(double x, double& s, double& c) {
    double rev = x * 0.15915494309189535; rev -= rint(rev);
    sincospi(2.0 * rev, &s, &c);
}

__device__ __forceinline__ void p0_transpose_item(const float* W, int N, bf16* WT, int ldk, LAS float* scr, int k0, int n0, int kdst, const float* gain, int lane) {
    const int cq = lane & 15, rs = lane >> 4;
    f32x4 v[16];
#pragma unroll
    for (int i = 0; i < 16; ++i) v[i] = MK_NTLD ? __builtin_nontemporal_load((const GAS f32x4*)(W + (size_t)(k0 + 4 * i + rs) * N + n0 + 4 * cq)) : *(const GAS f32x4*)(W + (size_t)(k0 + 4 * i + rs) * N + n0 + 4 * cq);
    if (gain) {
#pragma unroll
        for (int i = 0; i < 16; ++i) v[i] = v[i] * gain[4 * i + rs]; }
#pragma unroll
    for (int i = 0; i < 16; ++i) { LAS float* d = scr + (4 * i + rs) * 65 + 4 * cq; d[0] = v[i].x; d[1] = v[i].y; d[2] = v[i].z; d[3] = v[i].w; }
    LDS_WAIT(); asm volatile("" ::: "memory");
    const int c = lane & 7;
#pragma unroll
    for (int j = 0; j < 8; ++j) { const int n = (lane >> 3) + 8 * j; const LAS float* s = scr + (8 * c) * 65 + n;
        v4u o; o.x = pk2(s[0 * 65], s[1 * 65]); o.y = pk2(s[2 * 65], s[3 * 65]); o.z = pk2(s[4 * 65], s[5 * 65]); o.w = pk2(s[6 * 65], s[7 * 65]);
        *(GAS v4u*)(WT + (size_t)(n0 + n) * ldk + kdst + 8 * c) = o; }
    LDS_WAIT(); asm volatile("" ::: "memory");
}

template <int MODE  > __device__ __forceinline__ void p0_ssm_item(Frame& F, int g, int k, LAS float* scr) {
    const int n = F.lane;
    const double dt = exp((double)F.in[IN_LOGDT][g]);
    const double lr = (double)F.in[IN_ARE][g * 64 + n], li = (double)F.in[IN_AIM][g * 64 + n];
    const double zr = lr * dt, zi = li * dt;
    double s1, c1; sincos_red(zi, s1, c1);
    const double er = exp(zr), ar = er * c1, ai = er * s1;
    const double den = lr * lr + li * li;
    const double cfr = ((ar - 1.0) * lr + ai * li) / den, cfi = (ai * lr - (ar - 1.0) * li) / den;
    double sk, ck; sincos_red(zi * (double)k, sk, ck);
    const double ek = exp(zr * (double)k), pr_d = ek * ck, pi_d = ek * sk;
    const float pr = (float)pr_d, pi = (float)pi_d;
    bf16* KT = (bf16*)(F.ws + WS_KT); bf16* WET = (bf16*)(F.ws + WS_WET); bf16* GT = (bf16*)(F.ws + WS_G);
    const float vr = (float)(pr_d * cfr - pi_d * cfi), vi = (float)(pr_d * cfi + pi_d * cfr);
    const float* bre = F.in[IN_BRE] + (size_t)(g * 64 + n) * 16; const float* bim = F.in[IN_BIM] + (size_t)(g * 64 + n) * 16;
    float br[16], bi[16];
#pragma unroll
    for (int q = 0; q < 4; ++q) { const f32x4 a = ((const f32x4*)bre)[q], b = ((const f32x4*)bim)[q];
#pragma unroll
        for (int e = 0; e < 4; ++e) { br[4 * q + e] = a[e]; bi[4 * q + e] = b[e]; } }
    float crv[16], civ[16];
    { const float* cre = F.in[IN_CRE] + (size_t)g * 1024 + n; const float* cim = F.in[IN_CIM] + (size_t)g * 1024 + n;
#pragma unroll
      for (int p = 0; p < 16; ++p) { crv[p] = cre[p * 64]; civ[p] = cim[p * 64]; } }
    if (k == 32) {
        float* AL = (float*)(F.ws + WS_AL); AL[(g * 64 + n) * 2] = pr; AL[(g * 64 + n) * 2 + 1] = pi;
        unsigned* z = (unsigned*)(KT + (size_t)(g * 33) * 256); z[n] = 0u; z[n + 64] = 0u;
    }
    if ((MODE & 1) && k <= 31) {
        const int sg = 31 - k;
        unsigned wre[8], wim[8];
#pragma unroll
        for (int q = 0; q < 8; ++q) { const float r0 = vr * br[2 * q] - vi * bi[2 * q], r1 = vr * br[2 * q + 1] - vi * bi[2 * q + 1];
            const float i0 = vr * bi[2 * q] + vi * br[2 * q], i1 = vr * bi[2 * q + 1] + vi * br[2 * q + 1]; wre[q] = pk2(r0, r1); wim[q] = pk2(i0, i1); }
        v4u* wb = (v4u*)WET + (size_t)g * 4 * 32 * 64 + (size_t)sg * 64 + (n & 31);
        v4u* dre = wb + (size_t)(n >> 5) * 32 * 64; v4u* dim = wb + (size_t)(2 + (n >> 5)) * 32 * 64;
        dre[0] = (v4u){wre[0], wre[1], wre[2], wre[3]}; dre[32] = (v4u){wre[4], wre[5], wre[6], wre[7]};
        dim[0] = (v4u){wim[0], wim[1], wim[2], wim[3]}; dim[32] = (v4u){wim[4], wim[5], wim[6], wim[7]};
    }
    if ((MODE & 2) && k >= 1) {
#pragma unroll
        for (int p = 0; p < 16; ++p) { const float gr = crv[p] * pr - civ[p] * pi, gi = -(crv[p] * pi + civ[p] * pr);
            bf16* gb = GT + ((size_t)(g * 16 + ((k - 1) >> 1)) * 8 * 64 + (((k - 1) & 1) * 16 + p)) * 8;
            gb[((size_t)(n >> 4) * 64 + ((n >> 3) & 1) * 32) * 8 + (n & 7)] = (bf16)f2bf(gr); gb[((size_t)(4 + (n >> 4)) * 64 + ((n >> 3) & 1) * 32) * 8 + (n & 7)] = (bf16)f2bf(gi); }
    }
    if ((MODE & 4) && k <= 31) {
#pragma unroll
        for (int q = 0; q < 4; ++q) { f32x4 a, b;
#pragma unroll
            for (int e = 0; e < 4; ++e) { a[e] = crv[4 * q + e] * vr - civ[4 * q + e] * vi; b[e] = -(crv[4 * q + e] * vi + civ[4 * q + e] * vr); }
            *(LAS f32x4*)(scr + n * 16 + 4 * q) = a; *(LAS f32x4*)(scr + (64 + n) * 16 + 4 * q) = b;
            *(LAS f32x4*)(scr + 2048 + n * 16 + 4 * q) = (f32x4){br[4 * q], br[4 * q + 1], br[4 * q + 2], br[4 * q + 3]};
            *(LAS f32x4*)(scr + 2048 + (64 + n) * 16 + 4 * q) = (f32x4){bi[4 * q], bi[4 * q + 1], bi[4 * q + 2], bi[4 * q + 3]}; }
        LDS_WAIT(); asm volatile("" ::: "memory");
        f32x4 acc = {0.f, 0.f, 0.f, 0.f};
#pragma unroll 8
        for (int t = 0; t < 32; ++t) acc = __builtin_amdgcn_mfma_f32_16x16x4f32(scr[t * 64 + n], scr[2048 + t * 64 + n], acc, 0, 0, 0);
        const int pp = n & 15, p0 = 4 * (n >> 4);
#pragma unroll
        for (int r = 0; r < 4; ++r) { float mine = acc[r]; if (k == 0 && pp == p0 + r) mine += F.in[IN_SSMD][g * 16 + pp];
            KT[((size_t)(g * 33 + k + 1) * 16 + p0 + r) * 16 + pp] = (bf16)f2bf(mine); }
        LDS_WAIT(); asm volatile("" ::: "memory");
    }
}

__device__ __forceinline__ void p1_row(Frame& F, int m) {
    const int b = m >> 12; const float* mod = (const float*)(F.ws + WS_MOD) + (size_t)b * NMOD;
    const GAS f32x4* xr = (const GAS f32x4*)(F.in[IN_X] + (size_t)m * D) + F.lane;
    f32x4 v[8]; float s = 0.f;
#pragma unroll
    for (int j = 0; j < 8; ++j) { v[j] = (MK_NTLD & 2) ? __builtin_nontemporal_load(xr + 64 * j) : xr[64 * j]; s += (v[j].x * v[j].x + v[j].y * v[j].y) + (v[j].z * v[j].z + v[j].w * v[j].w); }
    const float rstd = 1.0f / sqrtf(wave_sum(s) * (1.f / D) + EPS);
    GAS unsigned long long* o8 = (GAS unsigned long long*)((bf16*)(F.ws + WS_H) + (size_t)m * D) + F.lane;
#pragma unroll
    for (int j = 0; j < 8; ++j) { const int c = 4 * F.lane + 256 * j;
        const f32x4 g = *(const f32x4*)(F.in[IN_GPREMIX] + c), sh = *(const f32x4*)(mod + c), sc = *(const f32x4*)(mod + D + c);
        const f32x4 h = v[j] * rstd * g * (sc + 1.0f) + sh;
        const unsigned long long hv = (unsigned long long)pk2(h.x, h.y) | ((unsigned long long)pk2(h.z, h.w) << 32); if (MK_NTLD & 16) __builtin_nontemporal_store(hv, o8 + 64 * j); else o8[64 * j] = hv; }
}

struct RowX { f32x4 x[8]; u32x2 a[8]; float part; };
__device__ __forceinline__ void row_load(Frame& F, RowX& R, int m, const bf16* abuf, const float* parts) {
    const GAS f32x4* xr = (const GAS f32x4*)(F.in[IN_X] + (size_t)m * D) + F.lane; const GAS u32x2* ar = (const GAS u32x2*)(abuf + (size_t)m * D) + F.lane;
#pragma unroll
    for (int j = 0; j < 8; ++j) { R.x[j] = (MK_NTLD & 2) ? __builtin_nontemporal_load(xr + 64 * j) : xr[64 * j]; R.a[j] = (MK_NTLD & 8) ? __builtin_nontemporal_load(ar + 64 * j) : ar[64 * j]; }
    R.part = F.lane < 32 ? parts[(size_t)m * 32 + F.lane] : 0.f;
}
__device__ __forceinline__ f32x4 bf4(u32x2 w) { return (f32x4){pg8::bf_lo(w.x), pg8::bf_hi(w.x), pg8::bf_lo(w.y), pg8::bf_hi(w.y)}; }
__device__ __forceinline__ void p8_block(Frame& F, int bc) {
    const int b = (bc * 64) >> 12; const float* mod = (const float*)(F.ws + WS_MOD) + (size_t)b * NMOD;
    LAS f32x4* C = (LAS f32x4*)(F.lds + RING_OFF);
    __syncthreads();
    { const int c = 4 * F.tid; C[F.tid] = *(const f32x4*)(mod + 2 * D + c) * *(const f32x4*)(F.in[IN_GPOSTMIX] + c);
      C[512 + F.tid] = *(const f32x4*)(F.in[IN_GPREMLP] + c) * (*(const f32x4*)(mod + 4 * D + c) + 1.0f); C[1024 + F.tid] = *(const f32x4*)(mod + 3 * D + c); }
    LDS_WAIT(); __syncthreads();
    const int m0 = bc * 64 + F.wave * 8;
    const bf16* mix = (const bf16*)(F.ws + WS_MIX); const float* parts = (const float*)(F.ws + WS_POUT);
    RowX cur, nxt; row_load(F, cur, m0, mix, parts);
#pragma unroll 1
    for (int r = 0; r < 8; ++r) {
        row_load(F, nxt, m0 + (r < 7 ? r + 1 : 7), mix, parts);
        const float rs_mix = 1.0f / sqrtf(wave_sum(cur.part) * (1.f / D) + EPS);
        float s = 0.f;
#pragma unroll
        for (int j = 0; j < 8; ++j) { const f32x4 v = cur.x[j] + C[F.lane + 64 * j] * (bf4(cur.a[j]) * rs_mix); cur.x[j] = v; s += (v.x * v.x + v.y * v.y) + (v.z * v.z + v.w * v.w); }
        const float rstd = 1.0f / sqrtf(wave_sum(s) * (1.f / D) + EPS);
        GAS unsigned long long* o8 = (GAS unsigned long long*)((bf16*)(F.ws + WS_H) + (size_t)(m0 + r) * D) + F.lane;
#pragma unroll
        for (int j = 0; j < 8; ++j) { const f32x4 h = cur.x[j] * rstd * C[512 + F.lane + 64 * j] + C[1024 + F.lane + 64 * j]; o8[64 * j] = (unsigned long long)pk2(h.x, h.y) | ((unsigned long long)pk2(h.z, h.w) << 32); }
        cur = nxt;
    }
}
__device__ __forceinline__ void p11_block(Frame& F, int bc) {
    const int b = (bc * 64) >> 12; const float* mod = (const float*)(F.ws + WS_MOD) + (size_t)b * NMOD;
    LAS f32x4* C = (LAS f32x4*)(F.lds + RING_OFF);
    __syncthreads();
    { const int c = 4 * F.tid; C[F.tid] = *(const f32x4*)(mod + 2 * D + c) * *(const f32x4*)(F.in[IN_GPOSTMIX] + c); C[512 + F.tid] = *(const f32x4*)(mod + 5 * D + c) * *(const f32x4*)(F.in[IN_GPOSTMLP] + c); }
    LDS_WAIT(); __syncthreads();
    const int m0 = bc * 64 + F.wave * 8;
    const bf16* mix = (const bf16*)(F.ws + WS_MIX); const float* parts = (const float*)(F.ws + WS_POUT);
    const bf16* y2 = (const bf16*)(F.ws + WS_H); const float* parts2 = (const float*)(F.ws + WS_PY2);
    RowX cur, nxt; u32x2 ycur[8], ynxt[8]; float pcur, pnxt = 0.f;
    row_load(F, cur, m0, mix, parts);
    { const GAS u32x2* yr = (const GAS u32x2*)(y2 + (size_t)m0 * D) + F.lane;
#pragma unroll
      for (int j = 0; j < 8; ++j) ycur[j] = (MK_NTLD & 8) ? __builtin_nontemporal_load(yr + 64 * j) : yr[64 * j];
      pcur = F.lane < 32 ? parts2[(size_t)m0 * 32 + F.lane] : 0.f; }
#pragma unroll 1
    for (int r = 0; r < 8; ++r) {
        { const int mn = m0 + (r < 7 ? r + 1 : 7); row_load(F, nxt, mn, mix, parts); const GAS u32x2* yr = (const GAS u32x2*)(y2 + (size_t)mn * D) + F.lane;
#pragma unroll
            for (int j = 0; j < 8; ++j) ynxt[j] = (MK_NTLD & 8) ? __builtin_nontemporal_load(yr + 64 * j) : yr[64 * j];
            pnxt = F.lane < 32 ? parts2[(size_t)mn * 32 + F.lane] : 0.f; }
        const float rs1 = 1.0f / sqrtf(wave_sum(cur.part) * (1.f / D) + EPS), rs2 = 1.0f / sqrtf(wave_sum(pcur) * (1.f / D) + EPS);
        GAS f32x4* orow = (GAS f32x4*)(F.out + (size_t)(m0 + r) * D) + F.lane;
#pragma unroll
        for (int j = 0; j < 8; ++j) { const f32x4 ov = cur.x[j] + C[F.lane + 64 * j] * (bf4(cur.a[j]) * rs1) + C[512 + F.lane + 64 * j] * (bf4(ycur[j]) * rs2); if (MK_NTLD & 4) __builtin_nontemporal_store(ov, orow + 64 * j); else orow[64 * j] = ov; }
        cur = nxt; pcur = pnxt;
#pragma unroll
        for (int j = 0; j < 8; ++j) ycur[j] = ynxt[j];
    }
}

__device__ __forceinline__ bf16x8 ld8(const bf16* p) { return *(const bf16x8*)p; }
__device__ __forceinline__ s16x4 vtr(LAS const unsigned char* p) { typedef short v4i16_t __attribute__((ext_vector_type(4))); return __builtin_bit_cast(s16x4, __builtin_amdgcn_ds_read_tr16_b64_v4i16((LAS v4i16_t*)p)); }
constexpr int ATT_UNITS = BATCH * 6 * 3 * 16, ATT_V = 49152;
struct AttU { int hh, g, dsh, res, i0; size_t rowb; };
__device__ __forceinline__ AttU att_decode(int u) { AttU a; const int b = u / 288; int rem = u - b * 288; a.hh = rem / 48; rem -= a.hh * 48; a.g = rem >> 4; const int blk = rem & 15;
    a.dsh = 2 * a.g; const int nb = 16 >> a.dsh; a.res = blk / nb; a.i0 = (blk - a.res * nb) * 256; a.rowb = (size_t)b * SEQ; return a; }
__device__ __forceinline__ int att_unit_of(Frame& F, int k) {
    if (F.G == 256) { if (k < 4) return F.vcu + 256 * k; if (F.vcu >= NG * BATCH && k < 8) return 1024 + (F.vcu - NG * BATCH) + 32 * (k - 4); return ATT_UNITS; }
    const int u = F.vcu + k * F.G; return u < ATT_UNITS ? u : ATT_UNITS;
}
__device__ __forceinline__ void att_issue(Frame& F, const AttU& a, u32x4 (&kv)[12], bf16x8 (&qn)[4]) {
    const bf16* proj = (const bf16*)(F.ws + WS_PROJ);
#pragma unroll
    for (int i = 0; i < 6; ++i) { const int ck = F.tid + 512 * i, row = ck >> 3, ch = ck & 7; int kidx = a.i0 - 128 + row; kidx = kidx < 0 ? 0 : kidx;
        const bf16* rp = proj + (a.rowb + ((size_t)kidx << a.dsh) + a.res) * NIN + a.hh * 64 + ch * 8;
        kv[i] = *(const u32x4*)(rp + COL_K); kv[6 + i] = *(const u32x4*)(rp + COL_V); }
    const bf16* qp = proj + (a.rowb + ((size_t)(a.i0 + 32 * F.wave + (F.lane & 31)) << a.dsh) + a.res) * NIN + (a.g * 6 + a.hh) * 64 + (F.lane >> 5) * 8;
#pragma unroll
    for (int kk = 0; kk < 4; ++kk) qn[kk] = ld8(qp + 16 * kk);
}
template <int MODE  > __device__ __forceinline__ void attn_phase(Frame& F) {
    const int lane = F.lane, r32 = lane & 31, hi = lane >> 5, w = F.wave;
    LAS unsigned char* L = F.lds + RING_OFF;
    u32x4 kv[12]; bf16x8 qn[4];
    int k_ = 0; int u = att_unit_of(F, 0);
    if (u < ATT_UNITS) { const AttU a = att_decode(u); att_issue(F, a, kv, qn); }
    int kch[4];
#pragma unroll
    for (int kk = 0; kk < 4; ++kk) kch[kk] = (32 * w + r32) * 128 + (((2 * kk + hi) ^ (r32 & 7)) * 16);
    const int grp = lane >> 4, tq = (grp >> 1) * 4 + ((lane & 15) >> 2), tp = lane & 3;
    int vch[2];
#pragma unroll
    for (int dt = 0; dt < 2; ++dt) vch[dt] = ATT_V + (32 * w + tq) * 128 + (((4 * dt + 2 * (grp & 1) + (tp >> 1)) ^ (tq & 7)) * 16) + 8 * (tp & 1);
    while (u < ATT_UNITS) {
        const AttU a = att_decode(u);
        __syncthreads();
#pragma unroll
        for (int i = 0; i < 6; ++i) { const int ck = F.tid + 512 * i, row = ck >> 3, ch = ck & 7; const int off = row * 128 + ((ch ^ (row & 7)) * 16);
            *(LAS u32x4*)(L + off) = kv[i]; *(LAS u32x4*)(L + ATT_V + off) = kv[6 + i]; }
        bf16x8 qf[4];
#pragma unroll
        for (int kk = 0; kk < 4; ++kk) qf[kk] = qn[kk];
        LDS_WAIT(); __syncthreads();
        const int un = att_unit_of(F, ++k_);
        if (un < ATT_UNITS) { const AttU an = att_decode(un); att_issue(F, an, kv, qn); }
        const int iq = a.i0 + 32 * w;
        const int jmin = (iq >= 128) ? 0 : (128 - iq) >> 5;
        f32x16 S[5];
#pragma unroll
        for (int j = 0; j < 5; ++j) S[j] = (f32x16){};
        if (MODE & 1) {
            bf16x8 kf[4][5];
#pragma unroll
            for (int j = 0; j < 5; ++j) kf[0][j] = *(const LAS bf16x8*)(L + kch[0] + j * 4096);
#pragma unroll
            for (int kk = 0; kk < 4; ++kk) {
                if (kk < 3) {
#pragma unroll
                    for (int j = 0; j < 5; ++j) kf[kk + 1][j] = *(const LAS bf16x8*)(L + kch[kk + 1] + j * 4096); }
                __builtin_amdgcn_sched_barrier(0);
#pragma unroll
                for (int j = 0; j < 5; ++j) S[j] = __builtin_amdgcn_mfma_f32_32x32x16_bf16(kf[kk][j], qf[kk], S[j], 0, 0, 0);
                __builtin_amdgcn_sched_barrier(0);
            } }
        const float NEG = -INFINITY; float mx = NEG, l = 1.f;
        if (MODE & 2) {
#pragma unroll
        for (int r = 0; r < 16; ++r) { const int bb = crow(r, hi); if (bb < r32) S[0][r] = NEG; if (bb > r32) S[4][r] = NEG; }
#pragma unroll
        for (int j = 0; j < 4; ++j) if (j < jmin) {
#pragma unroll
            for (int r = 0; r < 16; ++r) S[j][r] = NEG; }
        { float m0 = NEG, m1 = NEG;
#pragma unroll
          for (int j = 0; j < 5; ++j)
#pragma unroll
              for (int r = 0; r < 16; r += 4) { m0 = fmaxf(fmaxf(m0, S[j][r]), S[j][r + 1]); m1 = fmaxf(fmaxf(m1, S[j][r + 2]), S[j][r + 3]); }
          mx = fmaxf(m0, m1); }
        mx = fmaxf(mx, __shfl_xor(mx, 32));
        l = 0.f;
#pragma unroll
        for (int j = 0; j < 5; ++j)
#pragma unroll
            for (int r = 0; r < 16; ++r) { const float p = __builtin_amdgcn_exp2f(S[j][r] - mx); S[j][r] = p; l += p; }
        l += __shfl_xor(l, 32);
        } else { _Pragma("unroll") for (int j = 0; j < 5; ++j) asm volatile("" : "+v"(S[j])); }
        f32x16 O0 = (f32x16){}, O1 = (f32x16){}, O2 = (f32x16){}, O3 = (f32x16){};
        if (MODE & 4) {
            s16x4 vq[10][4];
#define ATT_VRD(st) do { _Pragma("unroll") for (int dt = 0; dt < 2; ++dt) { vq[st][2 * dt] = vtr(L + vch[dt] + (16 * (st)) * 128); vq[st][2 * dt + 1] = vtr(L + vch[dt] + (16 * (st) + 8) * 128); } } while (0)
            ATT_VRD(0); ATT_VRD(1);
#pragma unroll
            for (int st = 0; st < 10; ++st) {
                const int j = st >> 1, s = st & 1;
                if (st + 2 < 10) ATT_VRD(st + 2);
                bf16x8 pf;
#pragma unroll
                for (int e = 0; e < 8; e += 2) { const unsigned wd = pg8::cvt_pk_bf16(S[j][8 * s + e], S[j][8 * s + e + 1]); pf[e] = (short)(wd & 0xffffu); pf[e + 1] = (short)(wd >> 16); }
                __builtin_amdgcn_sched_barrier(0);
                const bf16x8 vf0 = {vq[st][0][0], vq[st][0][1], vq[st][0][2], vq[st][0][3], vq[st][1][0], vq[st][1][1], vq[st][1][2], vq[st][1][3]};
                const bf16x8 vf1 = {vq[st][2][0], vq[st][2][1], vq[st][2][2], vq[st][2][3], vq[st][3][0], vq[st][3][1], vq[st][3][2], vq[st][3][3]};
                if (s == 0) { O0 = __builtin_amdgcn_mfma_f32_32x32x16_bf16(vf0, pf, O0, 0, 0, 0); O1 = __builtin_amdgcn_mfma_f32_32x32x16_bf16(vf1, pf, O1, 0, 0, 0); }
                else { O2 = __builtin_amdgcn_mfma_f32_32x32x16_bf16(vf0, pf, O2, 0, 0, 0); O3 = __builtin_amdgcn_mfma_f32_32x32x16_bf16(vf1, pf, O3, 0, 0, 0); }
                __builtin_amdgcn_sched_barrier(0);
            }
#undef ATT_VRD
        }
        O0 = O0 + O2; O1 = O1 + O3;
        if (!(MODE & 8)) { asm volatile("" :: "v"(O0), "v"(O1), "v"(mx), "v"(l)); if (!(MODE & 4)) { _Pragma("unroll") for (int j = 0; j < 5; ++j) asm volatile("" :: "v"(S[j])); } u = un; continue; }
        const float il = 1.0f / l;
        const size_t qrow = a.rowb + ((size_t)(iq + r32) << a.dsh) + a.res;
        bf16* ob = (bf16*)(F.ws + WS_OBUF) + ((size_t)a.g * M + qrow) * NKV + a.hh * 64;
#pragma unroll
        for (int t = 0; t < 2; ++t) {
#pragma unroll
            for (int ip = 0; ip < 2; ++ip) {
                const f32x16& O = t == 0 ? O0 : O1;
                const unsigned a0 = pg8::cvt_pk_bf16(O[8 * ip] * il, O[8 * ip + 1] * il), a1 = pg8::cvt_pk_bf16(O[8 * ip + 2] * il, O[8 * ip + 3] * il);
                const unsigned b0 = pg8::cvt_pk_bf16(O[8 * ip + 4] * il, O[8 * ip + 5] * il), b1 = pg8::cvt_pk_bf16(O[8 * ip + 6] * il, O[8 * ip + 7] * il);
                const auto r0 = __builtin_amdgcn_permlane32_swap(a0, b0, false, false), r1 = __builtin_amdgcn_permlane32_swap(a1, b1, false, false);
                u32x4 wv;
                if (hi == 0) { wv.x = a0; wv.y = a1; wv.z = r0[1]; wv.w = r1[1]; } else { wv.x = r0[0]; wv.y = r1[0]; wv.z = b0; wv.w = b1; }
                *(u32x4*)(ob + 32 * t + 16 * ip + 8 * hi) = wv; } }
        if (hi == 0) ((float*)(F.ws + WS_LSE))[((size_t)a.g * M + qrow) * 8 + a.hh] = mx + __builtin_amdgcn_logf(l);
        u = un;
    }
    __syncthreads();
}

__device__ __forceinline__ void att_combine_rows(Frame& F, int m0) {
    const float* lse = (const float*)(F.ws + WS_LSE); const bf16* ob = (const bf16*)(F.ws + WS_OBUF);
    const int l = F.lane < 48 ? F.lane : 47, hd = l >> 3;
    u32x4 o[2][3]; float ls[2][3];
#pragma unroll
    for (int r = 0; r < 2; ++r)
#pragma unroll
        for (int g = 0; g < 3; ++g) { o[r][g] = *(const u32x4*)(ob + ((size_t)g * M + m0 + r) * NKV + 8 * l); ls[r][g] = lse[((size_t)g * M + m0 + r) * 8 + hd]; }
    const f32x4 g0 = *(const f32x4*)(F.in[IN_GATT] + 8 * l), g1 = *(const f32x4*)(F.in[IN_GATT] + 8 * l + 4);
#pragma unroll
    for (int r = 0; r < 2; ++r) {
        const float mx = fmaxf(ls[r][0], fmaxf(ls[r][1], ls[r][2])); const float w0 = __builtin_amdgcn_exp2f(ls[r][0] - mx), w1 = __builtin_amdgcn_exp2f(ls[r][1] - mx), w2 = __builtin_amdgcn_exp2f(ls[r][2] - mx);
        const float inv = 1.0f / (w0 + w1 + w2); const float a0 = w0 * inv, a1 = w1 * inv, a2 = w2 * inv;
        float v[8]; float ss = 0.f;
#pragma unroll
        for (int e = 0; e < 4; ++e) { const unsigned x0 = o[r][0][e], x1 = o[r][1][e], x2 = o[r][2][e];
            v[2 * e] = a0 * pg8::bf_lo(x0) + a1 * pg8::bf_lo(x1) + a2 * pg8::bf_lo(x2); v[2 * e + 1] = a0 * pg8::bf_hi(x0) + a1 * pg8::bf_hi(x1) + a2 * pg8::bf_hi(x2);
            ss += v[2 * e] * v[2 * e] + v[2 * e + 1] * v[2 * e + 1]; }
        if (F.lane >= 48) ss = 0.f;
        const float rstd = 1.0f / sqrtf(wave_sum(ss) * (1.f / NKV) + EPS);
        u32x4 wv; wv.x = pg8::cvt_pk_bf16(v[0] * rstd * g0.x, v[1] * rstd * g0.y); wv.y = pg8::cvt_pk_bf16(v[2] * rstd * g0.z, v[3] * rstd * g0.w);
        wv.z = pg8::cvt_pk_bf16(v[4] * rstd * g1.x, v[5] * rstd * g1.y); wv.w = pg8::cvt_pk_bf16(v[6] * rstd * g1.z, v[7] * rstd * g1.w);
        if (F.lane < 48) *(u32x4*)((bf16*)(F.ws + WS_AOUT) + (size_t)(m0 + r) * KOUT + 896 + 8 * l) = wv;
    }
}

constexpr int SA_E = 66560;
__device__ __forceinline__ float gelu_tanh(float x) { const float u = x * (2.3022082f + 0.1029432f * x * x); return x * __builtin_amdgcn_rcpf(1.0f + __builtin_amdgcn_exp2f(-u)); }
constexpr int SF_CY = 0, SF_U = 34816, SF_KT = 68096, SF_Y = 84992;
__device__ __forceinline__ void ssm_fused_block(Frame& F, int unit) {
    const int tid = F.tid, lane = F.lane, r32 = lane & 31, hi = lane >> 5, w = F.wave;
    const int g = unit >> 2, b = unit & 3;
    LAS unsigned char* L = F.lds + RING_OFF;
    {
        const int rt = w & 3, chf = w >> 2;
        const v4u* ap = (const v4u*)(F.ws + WS_WET) + (size_t)(g * 4 + rt) * 32 * 64 + lane;
        bf16x8 af[32];
#pragma unroll
        for (int sg = 0; sg < 32; ++sg) af[sg] = __builtin_bit_cast(bf16x8, ap[sg * 64]);
#pragma unroll 1
        for (int half = 0; half < 2; ++half) {
            const bf16* ut = (const bf16*)(F.ws + WS_UT) + ((size_t)g * M + b * SEQ + half * 2048) * 16;
            u32x4 su[8];
#pragma unroll
            for (int i = 0; i < 8; ++i) su[i] = *(const u32x4*)(ut + (size_t)(tid + 512 * i) * 8);
#pragma unroll
            for (int i = 0; i < 8; ++i) { const int ch = tid + 512 * i, tok = ch >> 1; *(LAS u32x4*)(L + (tok >> 5) * 1040 + (tok & 31) * 32 + (ch & 1) * 16) = su[i]; }
            LDS_WAIT(); __syncthreads();
            f32x16 acc = (f32x16){}, acc2 = (f32x16){};
            const LAS unsigned char* ub = L + (chf * 32 + r32) * 1040 + hi * 16;
#pragma unroll
            for (int sg = 0; sg < 32; sg += 2) { acc = __builtin_amdgcn_mfma_f32_32x32x16_bf16(af[sg], *(const LAS bf16x8*)(ub + sg * 32), acc, 0, 0, 0);
                                                 acc2 = __builtin_amdgcn_mfma_f32_32x32x16_bf16(af[sg + 1], *(const LAS bf16x8*)(ub + sg * 32 + 32), acc2, 0, 0, 0); }
            acc = acc + acc2;
            LAS float* El = (LAS float*)(L + SA_E) + (half * 64 + chf * 32 + r32) * 128 + rt * 32;
#pragma unroll
            for (int i = 0; i < 4; ++i) *(LAS f32x4*)(El + 8 * i + 4 * hi) = (f32x4){acc[4 * i], acc[4 * i + 1], acc[4 * i + 2], acc[4 * i + 3]};
            LDS_WAIT(); __syncthreads();
        }
    }
    const bf16* utb = (const bf16*)(F.ws + WS_UT) + ((size_t)g * M + b * SEQ) * 16;
    const bf16* KT = (const bf16*)(F.ws + WS_KT) + (size_t)g * 33 * 256;
    u32x4 su[4], sk[3];
#pragma unroll
    for (int i = 0; i < 3; ++i) { const int ch = tid + 512 * i; sk[i] = *(const u32x4*)(KT + (size_t)(ch < 1056 ? ch : 0) * 8); }
#pragma unroll
    for (int i = 0; i < 4; ++i) su[i] = *(const u32x4*)(utb + (size_t)(tid + 512 * i) * 8);
    bf16x8 gf[2][8];
#pragma unroll
    for (int h = 0; h < 2; ++h) { const int tp = h == 0 ? w : 15 - w; const v4u* gp = (const v4u*)(F.ws + WS_G) + (size_t)(g * 16 + tp) * 8 * 64 + lane;
#pragma unroll
        for (int kk = 0; kk < 8; ++kk) gf[h][kk] = __builtin_bit_cast(bf16x8, gp[kk * 64]); }
    if (w == 0) {
        const float* AL = (const float*)(F.ws + WS_AL); const float alr = AL[(g * 64 + lane) * 2], ali = AL[(g * 64 + lane) * 2 + 1];
        const LAS float* El = (const LAS float*)(L + SA_E); LAS bf16* CY = (LAS bf16*)(L + SF_CY);
        float cr = 0.f, ci = 0.f;
#pragma unroll 8
        for (int c = 0; c < 128; ++c) { CY[c * 136 + lane] = (bf16)f2bf(cr); CY[c * 136 + 64 + lane] = (bf16)f2bf(ci);
            const float er = El[c * 128 + lane], ei = El[c * 128 + 64 + lane]; const float nr = alr * cr - ali * ci + er, ni = alr * ci + ali * cr + ei; cr = nr; ci = ni; }
    }
    LDS_WAIT(); __syncthreads();
#pragma unroll
    for (int i = 0; i < 3; ++i) { const int ch = tid + 512 * i; if (ch < 1056) *(LAS u32x4*)(L + SF_KT + ch * 16) = sk[i]; }
    const LAS unsigned char* ub = L + SF_U + r32 * 1040 + hi * 16;
#pragma unroll 1
    for (int cbl = 0; cbl < 4; ++cbl) {
#pragma unroll
        for (int i = 0; i < 4; ++i) { const int ch = tid + 512 * i, tok = ch >> 1; *(LAS u32x4*)(L + SF_U + (tok >> 5) * 1040 + (tok & 31) * 32 + (ch & 1) * 16) = su[i]; }
        LDS_WAIT(); __syncthreads();
        if (cbl < 3) {
#pragma unroll
            for (int i = 0; i < 4; ++i) su[i] = *(const u32x4*)(utb + (size_t)(cbl + 1) * 1024 * 16 + (size_t)(tid + 512 * i) * 8); }
        const LAS unsigned char* cyb = L + SF_CY + (32 * cbl + r32) * 272 + hi * 16;
#pragma unroll
        for (int h = 0; h < 2; ++h) {
            const int tau0 = 2 * (h == 0 ? w : 15 - w);
            f32x16 acc = (f32x16){}, acc2 = (f32x16){};
#pragma unroll
            for (int kk = 0; kk < 8; kk += 2) { acc = __builtin_amdgcn_mfma_f32_32x32x16_bf16(gf[h][kk], *(const LAS bf16x8*)(cyb + 32 * kk), acc, 0, 0, 0);
                                                acc2 = __builtin_amdgcn_mfma_f32_32x32x16_bf16(gf[h][kk + 1], *(const LAS bf16x8*)(cyb + 32 * kk + 32), acc2, 0, 0, 0); }
            const LAS unsigned char* kb = L + SF_KT + (tau0 + 1) * 512 + r32 * 32 + hi * 16;
#pragma unroll 2
            for (int sg = 0; sg < tau0 + 2; sg += 2) {
                acc = __builtin_amdgcn_mfma_f32_32x32x16_bf16(*(const LAS bf16x8*)(kb - sg * 512), *(const LAS bf16x8*)(ub + sg * 32), acc, 0, 0, 0);
                acc2 = __builtin_amdgcn_mfma_f32_32x32x16_bf16(*(const LAS bf16x8*)(kb - (sg + 1) * 512), *(const LAS bf16x8*)(ub + (sg + 1) * 32), acc2, 0, 0, 0); }
            acc = acc + acc2;
#pragma unroll
            for (int i = 0; i < 4; ++i) {
                u32x2 o; o.x = pg8::cvt_pk_bf16(gelu_tanh(acc[4 * i]), gelu_tanh(acc[4 * i + 1])); o.y = pg8::cvt_pk_bf16(gelu_tanh(acc[4 * i + 2]), gelu_tanh(acc[4 * i + 3]));
                *(LAS u32x2*)(L + SF_Y + r32 * 1040 + (tau0 + (i >> 1)) * 32 + (8 * (i & 1) + 4 * hi) * 2) = o; }
        }
        LDS_WAIT(); __syncthreads();
        bf16* yb = (bf16*)(F.ws + WS_YBUF) + ((size_t)b * SEQ + cbl * 1024) * NU + g * 16;
#pragma unroll
        for (int i = 0; i < 4; ++i) { const int ch = tid + 512 * i, tok = ch >> 1;
            *(u32x4*)(yb + (size_t)tok * NU + 8 * (ch & 1)) = *(const LAS u32x4*)(L + SF_Y + (tok >> 5) * 1040 + (tok & 31) * 32 + (ch & 1) * 16); }
    }
    __syncthreads();
}

__device__ __forceinline__ void p0_gemv_item(Frame& F, int item) {
    LAS float* sc = (LAS float*)(F.lds + RING_OFF); LAS float* red = (LAS float*)(F.lds + RING_OFF + 32768);
    const float* W = F.in[IN_WADA]; const int n0 = item * 64;
    const int cg = F.lane & 15, rsub = F.lane >> 4;
    f32x4 acc[4] = {{0.f, 0.f, 0.f, 0.f}, {0.f, 0.f, 0.f, 0.f}, {0.f, 0.f, 0.f, 0.f}, {0.f, 0.f, 0.f, 0.f}};
#pragma unroll 8
    for (int it = 0; it < 64; ++it) { const int k = it * 32 + F.wave * 4 + rsub;
        const f32x4 wv = MK_NTLD ? __builtin_nontemporal_load((const f32x4*)(W + (size_t)k * NMOD + n0 + 4 * cg)) : *(const f32x4*)(W + (size_t)k * NMOD + n0 + 4 * cg);
#pragma unroll
        for (int b = 0; b < 4; ++b) acc[b] = acc[b] + wv * sc[b * D + k]; }
#pragma unroll
    for (int b = 0; b < 4; ++b)
#pragma unroll
        for (int e = 0; e < 4; ++e) { float v = acc[b][e]; v += __shfl_xor(v, 16); v += __shfl_xor(v, 32); acc[b][e] = v; }
    if (rsub == 0) {
#pragma unroll
        for (int b = 0; b < 4; ++b) *(LAS f32x4*)(red + (F.wave * 4 + b) * 64 + 4 * cg) = acc[b]; }
    __syncthreads();
    if (F.tid < 256) { const int b = F.tid >> 6, c = F.tid & 63; float s = F.in[IN_BADA][n0 + c];
#pragma unroll
        for (int w = 0; w < 8; ++w) s += red[(w * 4 + b) * 64 + c];
        ((float*)(F.ws + WS_MOD))[(size_t)b * NMOD + n0 + c] = s; }
    asm volatile("s_waitcnt vmcnt(0)" ::: "memory");
    __syncthreads();
    if (F.tid == 0) {
        __builtin_amdgcn_fence(__ATOMIC_RELEASE, "agent"); asm volatile("s_waitcnt vmcnt(0)" ::: "memory");
        __hip_atomic_fetch_add(F.ctl + CW_GEMV, 1u, RLX_AGENT); }
}
__device__ __forceinline__ void gemv_wait(Frame& F) {
    if (F.tid == 0) { unsigned sp = 0;
        while (__hip_atomic_load(F.ctl + CW_GEMV, RLX_AGENT) < (unsigned)(NMOD / 64)) { __builtin_amdgcn_s_sleep(2); if (++sp > (1u << 22)) { __hip_atomic_store(F.ctl + CW_TMO, 0x6E3Fu, RLX_AGENT); break; } }
        __builtin_amdgcn_fence(__ATOMIC_ACQUIRE, "agent"); asm volatile("s_waitcnt vmcnt(0)" ::: "memory"); }
    __syncthreads();
}

__device__ __forceinline__ void p0_prologue(Frame& F) {
    constexpr int NGEMV = NMOD / 64;
    __syncthreads();
    if ((int)blockIdx.x < NGEMV) {
        LAS float* sc = (LAS float*)(F.lds + RING_OFF);
        for (int i = F.tid; i < BATCH * D; i += NWAVES * 64) { const float c = F.in[IN_C][i]; sc[i] = c / (1.0f + __expf(-c)); }
        __syncthreads();
        for (int r_ = 0; r_ < (MK_P0SUB == 1 ? 2 : 1); ++r_) for (int it = blockIdx.x; it < NGEMV; it += F.G) p0_gemv_item(F, it);
    }
    LAS float* scr = (LAS float*)(F.lds + RING_OFF + F.wave * 16640);
    const int gw = F.vcu * NWAVES + F.wave, NGW = F.G * NWAVES;
    if (!MK_SSMTAIL) for (int it = gw; it < NG * 33; it += NGW) p0_ssm_item<7>(F, it / 33, it % 33, scr);
    if (MK_P0SUB == 2) for (int it = gw; it < NG * 33; it += NGW) p0_ssm_item<MK_P0MODE>(F, it / 33, it % 33, scr);
    constexpr int I_IN = (D / 64) * (NIN / 64);
    bf16* WIN = (bf16*)(F.ws + WS_WIN);
    for (int r_ = 0; r_ < (MK_P0SUB == 3 ? 2 : 1); ++r_) for (int r = gw; r < I_IN; r += NGW) { const int nb = NIN / 64; p0_transpose_item(F.in[IN_WIN], NIN, WIN, D, scr, 64 * (r / nb), 64 * (r % nb), 64 * (r / nb), nullptr, F.lane); }
    { const int gt = gw * 64 + F.lane, NT = NGW * 64; float* rope = (float*)(F.ws + WS_ROPE); const int* pos = (const int*)F.in[IN_POS];
      for (int r_ = 0; r_ < (MK_P0SUB == 4 ? 2 : 1); ++r_) for (int it = gt; it < M * 8; it += NT) { const int row = it >> 3, j = it & 7;
          const float f = (float)exp(-(double)j * 0.125 * 13.122363377404328);
          const float ang = (float)pos[row] * f; double s, c; sincos_red((double)ang, s, c);
          rope[row * 16 + j] = (float)c; rope[row * 16 + 8 + j] = (float)s; } }
}

__device__ __forceinline__ void late_weight_items(Frame& F, int wi, int nw) {
    LAS float* scr = (LAS float*)(F.lds + RING_OFF + F.wave * 16640);
    constexpr int I_GLU = (NU / 64) * (NU / 64), I_OUT = (KOUT / 64) * (D / 64), I_ZP = 128;
    bf16* WGLU = (bf16*)(F.ws + WS_WGLU); bf16* WOUT = (bf16*)(F.ws + WS_WOUT);
    for (int it = wi; it < I_GLU + I_OUT + I_ZP; it += nw) {
        int r = it;
        if (r < I_GLU) { const int nb = NU / 64; p0_transpose_item(F.in[IN_WGLU], NU, WGLU, NU, scr, 64 * (r / nb), 64 * (r % nb), 64 * (r / nb), nullptr, F.lane); continue; } r -= I_GLU;
        if (r < I_OUT) { const int nb = D / 64; const int k0 = 64 * (r / nb);
            p0_transpose_item(F.in[IN_WOUT], D, WOUT, KOUT, scr, k0, 64 * (r % nb), k0 < NKV ? k0 + NU : k0 - NKV, k0 < NKV ? nullptr : F.in[IN_GSSM] + (k0 - NKV), F.lane); continue; } r -= I_OUT;
        { v4u* z = (v4u*)(WGLU + (size_t)(NU + r) * NU); for (int i = F.lane; i < NU * 2 / 16; i += 64) z[i] = (v4u){0u, 0u, 0u, 0u}; }
    }
}
__device__ __forceinline__ void mlp_weight_items(Frame& F, int wi, int nw, int lo_, int hi_) {
    LAS float* scr = (LAS float*)(F.lds + RING_OFF + F.wave * 16640);
    constexpr int I_1 = (D / 64) * (FF / 64);
    bf16* W1 = (bf16*)(F.ws + WS_W1); bf16* W2 = (bf16*)(F.ws + WS_W2);
    for (int it = lo_ + wi; it < hi_; it += nw) {
        if (it < I_1) { const int nb = FF / 64; p0_transpose_item(F.in[IN_W1], FF, W1, D, scr, 64 * (it / nb), 64 * (it % nb), 64 * (it / nb), nullptr, F.lane); }
        else { const int r = it - I_1, nb = D / 64; p0_transpose_item(F.in[IN_W2], D, W2, FF, scr, 64 * (r / nb), 64 * (r % nb), 64 * (r / nb), nullptr, F.lane); }
    }
}

struct Args { const float* in[25]; float* out; unsigned char* ws; int ph_lo, ph_hi, li, pad; };
__global__ void __launch_bounds__(NWAVES * 64, 2) mk_fwd(Args args) {
    extern __shared__ __attribute__((aligned(16))) unsigned char lds[];
    Frame F;
    F.lds = (LAS unsigned char*)lds;
    F.MISC = (volatile LAS unsigned*)(F.lds + MISC_OFF);
    F.tid = threadIdx.x; F.lane = F.tid & 63; F.wave = __builtin_amdgcn_readfirstlane(F.tid >> 6);
    F.G = gridDim.x; { const int bx = blockIdx.x; F.vcu = (F.G % 8 == 0) ? (bx % 8) * (F.G / 8) + bx / 8 : bx; }
    unsigned char* ws = args.ws; F.ws = ws; F.out = args.out;
    F.in = (KARGP)__builtin_amdgcn_kernarg_segment_ptr();
#define RELOAD_IN() asm volatile("" : "+s"(F.in))
    F.ctl = (gu32*)(ws + WS_CTL);
    for (int u = F.tid; u < (LDS_BYTES - LDSCTL_OFF) / 4; u += NWAVES * 64) ((LAS unsigned*)(F.lds + LDSCTL_OFF))[u] = 0u;
    __syncthreads();
    XcdBarrier bar; bar.bar = (unsigned*)(F.ctl + CW_BAR); bar.x = 0; bar.st = nullptr;
    if (!MK_PER_PHASE) bar = xcd_barrier_post((unsigned*)(F.ctl + CW_BAR), F.MISC + 8);
    if (!MK_PER_PHASE && MK_LOCALBAR && F.tid == 0) __hip_atomic_store(F.ctl + CW_XTAB + blockIdx.x, bar.x + 1u, RLX_AGENT);
#define SEAM_BAR_X(PUB_, WAIT_) do { if (MK_PER_PHASE) { if (F.tid == 0) __hip_atomic_store(F.ctl + CW_TMO, 0xBADBA0u, RLX_AGENT); } else if (MK_LOCALBAR && F.MISC[12] != 0u) { xcc_local_barrier_x<PUB_, WAIT_>(bar, (unsigned*)F.ctl, (unsigned*)(F.ctl + CW_P7DONE), (unsigned*)(F.ctl + CW_P7DONE)); } else { xcd_barrier(bar); } } while (0)
#define SEAM_BAR() do { if (MK_PER_PHASE) { if (F.tid == 0) __hip_atomic_store(F.ctl + CW_TMO, 0xBADBA0u, RLX_AGENT); } else if (MK_LOCALBAR && F.MISC[12] != 0u) { xcc_local_barrier(bar, (unsigned*)F.ctl); } else { xcd_barrier(bar); } } while (0)
#define GRID_BAR() do { if (MK_PER_PHASE) { if (F.tid == 0) __hip_atomic_store(F.ctl + CW_TMO, 0xBADBA0u, RLX_AGENT); } else { xcd_barrier(bar); } } while (0)
    const int lo = args.ph_lo, hi = args.ph_hi;
#ifndef MK_PHASE_MASK
#define MK_PHASE_MASK 0xFFF
#endif
#define IN(k) (((MK_PHASE_MASK >> (k)) & 1) && lo <= (k) && (k) < hi)
#define BOTH(k) (IN(k) && IN((k) + 1))
    const int gw = F.vcu * NWAVES + F.wave, NGW = F.G * NWAVES;

    if (IN(0)) { RELOAD_IN(); for (int rep_ = 0; rep_ < ((MK_DUP == 0) ? 2 : 1); ++rep_) { p0_prologue(F); }
        if (!MK_PER_PHASE) { gemv_wait(F);
            if (MK_P1BAL && F.G == 256) {
                for (int m = gw; m < 7 * NGW; m += NGW) p1_row(F, m);
                if ((int)blockIdx.x >= NMOD / 64) { const int fw = ((int)blockIdx.x - NMOD / 64) * NWAVES + F.wave; for (int m = 7 * NGW + fw; m < M; m += (F.G - NMOD / 64) * NWAVES) p1_row(F, m); } }
            else for (int m = gw; m < M; m += NGW) p1_row(F, m); }
        if (BOTH(0)) { GRID_BAR();
            if (!MK_PER_PHASE && MK_LOCALBAR) {
                int ok = (F.G == 256) ? 1 : 0;
                if (ok && F.tid < 256) { const unsigned a = xb_ld((unsigned*)(F.ctl + CW_XTAB + F.tid)), r = xb_ld((unsigned*)(F.ctl + CW_XTAB + (F.tid & 7))); ok = (a != 0u && a == r) ? 1 : 0; }
                ok = __syncthreads_and(ok);
                if (F.tid == 0) F.MISC[12] = ok ? 1u : 0u;
                __syncthreads(); } } }
    if (IN(1) && MK_PER_PHASE) { RELOAD_IN(); for (int m = gw; m < M; m += NGW) p1_row(F, m); }
    if (IN(2)) { RELOAD_IN(); for (int rep_ = 0; rep_ < ((MK_DUP == 2) ? 2 : 1); ++rep_) {
        pg8::Gemm g{(const pg8::bf16_t*)(ws + WS_H), (const pg8::bf16_t*)(ws + WS_WIN), M, NIN, D}; pg8::StaticOrder S; S.init(M, NIN, F.G, (int)blockIdx.x); S.wgm = MK_WGM2;
        pg8::EpiProj E{(pg8::bf16_t*)(ws + WS_PROJ), (const float*)(ws + WS_ROPE), QSCALE, (pg8::bf16_t*)(ws + WS_UT)};
        pg8::gemm_phase<pg8::EpiProj, pg8::StaticOrder, PG8_ALIGN, PG8_SP2>(F.lds + RING_OFF, g, S, E);
        { constexpr int NWG = (M / 256) * (NIN / 256); const int nidle = F.G - NWG % F.G;
          if (NWG % F.G != 0 && (int)blockIdx.x >= NWG % F.G) { const int wi_ = ((int)blockIdx.x - NWG % F.G) * NWAVES + F.wave, nw_ = nidle * NWAVES;
              if (MK_SSMTAIL) { LAS float* scr_ = (LAS float*)(F.lds + RING_OFF + F.wave * 16640); for (int it = wi_; it < NG * 33; it += nw_) p0_ssm_item<7>(F, it / 33, it % 33, scr_); }
              mlp_weight_items(F, wi_, nw_, 0, MK_W1TAIL); }
          else if (NWG % F.G == 0) { if (MK_SSMTAIL) { LAS float* scr_ = (LAS float*)(F.lds + RING_OFF + F.wave * 16640); for (int it = gw; it < NG * 33; it += NGW) p0_ssm_item<7>(F, it / 33, it % 33, scr_); } mlp_weight_items(F, gw, NGW, 0, 4096); } }
        } if (BOTH(2)) GRID_BAR();
    }
    if (IN(3)) { RELOAD_IN(); for (int rep_ = 0; rep_ < ((MK_DUP == 3) ? 2 : 1); ++rep_) {
        for (int un = F.vcu; un < NG * BATCH; un += F.G) ssm_fused_block(F, un);
        attn_phase<15>(F); if (MK_SUB == 32) attn_phase<MK_AMODE>(F);
        late_weight_items(F, gw, NGW); mlp_weight_items(F, gw, NGW, MK_W1TAIL, 8192);
        } if (IN(3) && IN(6)) GRID_BAR();
    }
    if (IN(6)) { RELOAD_IN(); for (int rep_ = 0; rep_ < ((MK_DUP == 6) ? 2 : 1); ++rep_) {
        if (F.G == 256) { for (int k_ = 0; k_ < 4; ++k_) att_combine_rows(F, 2048 * (F.vcu >> 5) + 512 * k_ + 2 * (gw & 255)); }
        else for (int m = 2 * gw; m < M; m += 2 * NGW) att_combine_rows(F, m);
        pg8::Gemm g{(const pg8::bf16_t*)(ws + WS_YBUF), (const pg8::bf16_t*)(ws + WS_WGLU), M, NGLU_PAD, NU}; pg8::StaticOrder S; S.init(M, NGLU_PAD, F.G, (int)blockIdx.x);
        pg8::EpiGlu E{(pg8::bf16_t*)(ws + WS_AOUT), (const pg8::bf16_t*)(ws + WS_YBUF), F.in[IN_BGLU], (float*)(ws + WS_PGLU)};
        pg8::gemm_phase<pg8::EpiGlu, pg8::StaticOrder, PG8_ALIGN, PG8_SP2>(F.lds + RING_OFF, g, S, E);
        } if (BOTH(6)) SEAM_BAR();
    }
    if (IN(7)) { RELOAD_IN(); for (int rep_ = 0; rep_ < ((MK_DUP == 7) ? 2 : 1); ++rep_) {
        pg8::Gemm g{(const pg8::bf16_t*)(ws + WS_AOUT), (const pg8::bf16_t*)(ws + WS_WOUT), M, D, KOUT}; pg8::StaticOrder S; S.init(M, D, F.G, (int)blockIdx.x); S.wgm = MK_WGM7;
        typedef pg8::EpiGen<0, true, 14> Ep; Ep E{(pg8::bf16_t*)(ws + WS_MIX), D, (float*)(ws + WS_POUT), 32, (const float*)(ws + WS_PGLU), 1.0f / NU, EPS};
        pg8::gemm_phase<Ep, pg8::StaticOrder, PG8_ALIGN, PG8_SP2>(F.lds + RING_OFF, g, S, E);
        } if (BOTH(7)) SEAM_BAR_X(true, false);
    }
    if (IN(8)) { RELOAD_IN(); for (int rep_ = 0; rep_ < ((MK_DUP == 8) ? 2 : 1); ++rep_) { for (int bc = F.vcu; bc < M / 64; bc += F.G) p8_block(F, bc); } if (BOTH(8)) SEAM_BAR_X(false, true);     }
    if (MK_SUB == 99 && !MK_PER_PHASE) { for (int i_ = 0; i_ < 10; ++i_) GRID_BAR(); }
    if (IN(9)) { RELOAD_IN(); for (int rep_ = 0; rep_ < ((MK_DUP == 9) ? 2 : 1); ++rep_) {
        pg8::Gemm g{(const pg8::bf16_t*)(ws + WS_H), (const pg8::bf16_t*)(ws + WS_W1), M, FF, D}; pg8::StaticOrder S; S.init(M, FF, F.G, (int)blockIdx.x); S.wgm = MK_WGM9;
        typedef pg8::EpiGen<2, false, 0, MK_NT9> Ep; Ep E{(pg8::bf16_t*)(ws + WS_HID), FF, nullptr, 0, nullptr, 0.f, 0.f};
        if (MK_SUB == 91) { for (int r_ = 0; r_ < 8; ++r_) { S.r0 = r_; S.nr = 1; pg8::gemm_phase<Ep, pg8::StaticOrder, PG8_ALIGN, PG8_SP2>(F.lds + RING_OFF, g, S, E); if (r_ < 7) GRID_BAR(); } }
        else pg8::gemm_phase<Ep, pg8::StaticOrder, PG8_ALIGN, PG8_SP2>(F.lds + RING_OFF, g, S, E);
        if (MK_GPROBE > 0) pg8::gemm_phase<Ep, pg8::StaticOrder, PG8_ALIGN, PG8_SP2, MK_GPROBE>(F.lds + RING_OFF, g, S, E);
        } if (BOTH(9)) SEAM_BAR();
    }
    if (IN(10)) { RELOAD_IN(); for (int rep_ = 0; rep_ < ((MK_DUP == 10) ? 2 : 1); ++rep_) {
        pg8::Gemm g{(const pg8::bf16_t*)(ws + WS_HID), (const pg8::bf16_t*)(ws + WS_W2), M, D, FF}; pg8::StaticOrder S; S.init(M, D, F.G, (int)blockIdx.x); S.wgm = MK_WGM10; S.rev = MK_REV10;
        typedef pg8::EpiGen<0, true, 0> Ep; Ep E{(pg8::bf16_t*)(ws + WS_H), D, (float*)(ws + WS_PY2), 32, nullptr, 0.f, 0.f};
        pg8::gemm_phase<Ep, pg8::StaticOrder, PG8_ALIGN, PG8_SP2, 0, MK_AUX10>(F.lds + RING_OFF, g, S, E);
        } if (BOTH(10)) SEAM_BAR();
    }
    if (IN(11)) { RELOAD_IN(); for (int rep_ = 0; rep_ < ((MK_DUP == 11) ? 2 : 1); ++rep_) { for (int bc = F.vcu; bc < M / 64; bc += F.G) p11_block(F, bc); } }
#undef IN
#undef BOTH
}

extern "C" void kernel_launch(void* const* d_in, const int* in_sizes, int n_in, void* d_out, int out_size, void* d_ws, size_t ws_size, hipStream_t stream) {
    static int grid = 0;
    if (grid == 0) {
        if (n_in != 25 || in_sizes[0] != M * D || out_size != M * D || ws_size < WS_END) { fprintf(stderr, "kernel_launch: unexpected shapes: n_in %d in0 %d out %d ws %zu (need %zu)\n", n_in, n_in > 0 ? in_sizes[0] : -1, out_size, ws_size, (size_t)WS_END); grid = -1; return; }
        int dev = 0, cus = 0, per_cu = 0;
        if (hipGetDevice(&dev) != hipSuccess || hipDeviceGetAttribute(&cus, hipDeviceAttributeMultiprocessorCount, dev) != hipSuccess) { fprintf(stderr, "kernel_launch: device query failed\n"); grid = -1; return; }
        if (hipFuncSetAttribute((const void*)mk_fwd, hipFuncAttributeMaxDynamicSharedMemorySize, LDS_BYTES) != hipSuccess) { fprintf(stderr, "kernel_launch: hipFuncSetAttribute failed\n"); grid = -1; return; }
        if (hipOccupancyMaxActiveBlocksPerMultiprocessor(&per_cu, (const void*)mk_fwd, NWAVES * 64, LDS_BYTES) != hipSuccess || per_cu < 1) { fprintf(stderr, "kernel_launch: occupancy query reports %d blocks per CU\n", per_cu); }
        (void)hipGetLastError();
        grid = cus;
    }
    if (grid < 0) return;
    if (hipMemsetAsync((char*)d_ws + WS_CTL, 0, CTL_ZERO_BYTES, stream) != hipSuccess) { fprintf(stderr, "kernel_launch: memset failed\n"); return; }
    Args a{};
    for (int i = 0; i < 25; ++i) a.in[i] = (const float*)d_in[i];
    a.out = (float*)d_out; a.ws = (unsigned char*)d_ws;
#if MK_PER_PHASE
    for (int p = 0; p < N_PHASES; ++p) { a.ph_lo = p; a.ph_hi = p + 1; a.li = p; hipLaunchKernelGGL(mk_fwd, dim3(grid), dim3(NWAVES * 64), LDS_BYTES, stream, a); }
#else
    a.ph_lo = 0; a.ph_hi = N_PHASES; a.li = 0;
    hipLaunchKernelGGL(mk_fwd, dim3(grid), dim3(NWAVES * 64), LDS_BYTES, stream, a);
#endif
    const hipError_t le = hipPeekAtLastError();
    if (le != hipSuccess) fprintf(stderr, "kernel_launch: launch failed: %s\n", hipGetErrorName(le));
}
```
